# Optimizing an MI355X kernel written in HIP

```python
import jax, jax.numpy as jnp
from jax import lax
import numpy as np

D_MODEL = 1024
BATCH = 32
SEQ = 2048
DEPTH = 1

D_MIX = D_MODEL
MLA_HEADS = 4
MLA_NOPE = 128
MLA_ROPE = 64
MLA_V = 128
MLA_WIDTH = MLA_HEADS * MLA_V
Q_LORA = 256
KV_LORA = 128
ROPE_THETA = 10000.0
Q_BLOCK = 128
RW_HEAD = 64
RW_WIDTH = D_MIX - MLA_WIDTH
RW_HEADS = RW_WIDTH // RW_HEAD
W_LORA = 64
A_LORA = 64
RW_GN_EPS = 64e-5
NORM_EPS = 1e-6
MLA_COLS = Q_LORA + KV_LORA + MLA_ROPE
RW_SHIFT_COLS = 3 * RW_WIDTH + W_LORA + A_LORA
GATE_COLS = D_MIX
D_IN = MLA_COLS + RW_SHIFT_COLS + GATE_COLS

kernel_name = 'hymba_mla_rwkv7_sandwich'


def rmsnorm(x, g):
    xf = x.astype(jnp.float32)
    y = xf * lax.rsqrt(jnp.mean(xf * xf, axis=-1, keepdims=True) + NORM_EPS)
    return (y * g.astype(jnp.float32)).astype(x.dtype)


def rope_tables(positions):
    inv_freq = ROPE_THETA ** (-jnp.arange(0, MLA_ROPE, 2, dtype=jnp.float32) / MLA_ROPE)
    ang = positions.astype(jnp.float32)[..., None] * inv_freq
    ang = jnp.concatenate([ang, ang], axis=-1)
    return jnp.cos(ang), jnp.sin(ang)


def apply_rope(x, cos, sin):
    x1, x2 = jnp.split(x, 2, axis=-1)
    rot = jnp.concatenate([-x2, x1], axis=-1)
    return (x.astype(jnp.float32) * cos + rot.astype(jnp.float32) * sin).astype(x.dtype)


def token_shift(p):
    return jnp.pad(p[:, :-1], ((0, 0), (1, 0), (0, 0)))


def mla_attention(q_nope, q_rope, k_nope, k_rope, v):
    T = q_nope.shape[1]
    scale = (MLA_NOPE + MLA_ROPE) ** -0.5
    outs = []
    for i in range(T // Q_BLOCK):
        s, e = i * Q_BLOCK, (i + 1) * Q_BLOCK
        scores = (jnp.einsum('bqhd,bkhd->bhqk', q_nope[:, s:e], k_nope[:, :e])
                  + jnp.einsum('bqhr,bkr->bhqk', q_rope[:, s:e], k_rope[:, :e])).astype(jnp.float32) * scale
        mask = (s + jnp.arange(Q_BLOCK))[:, None] >= jnp.arange(e)[None, :]
        scores = jnp.where(mask, scores, -jnp.inf)
        probs = jax.nn.softmax(scores, axis=-1).astype(v.dtype)
        outs.append(jnp.einsum('bhqk,bkhd->bqhd', probs, v[:, :e]))
    return jnp.concatenate(outs, axis=1)


def wkv7_scan(r, w, k, v, kk, a):
    B, T, H, N = r.shape

    def step(S, inp):
        r_t, w_t, k_t, v_t, kk_t, a_t = inp
        sa = jnp.einsum('bhvk,bhk->bhv', S, -kk_t)
        S = (S * w_t[:, :, None, :] + sa[..., None] * (kk_t * a_t)[:, :, None, :]
             + v_t[..., None] * k_t[:, :, None, :])
        return S, jnp.einsum('bhvk,bhk->bhv', S, r_t)

    xs = tuple(jnp.moveaxis(t.astype(jnp.float32), 1, 0) for t in (r, w, k, v, kk, a))
    S0 = jnp.zeros((B, H, N, N), jnp.float32)
    _, ys = lax.scan(step, S0, xs)
    return jnp.moveaxis(ys, 0, 1)


def setup_inputs(seed: int = 0) -> dict:
    key = jax.random.key(seed)
    ks = jax.random.split(key, 24)
    L = DEPTH
    f32 = jnp.float32

    def nrm(k, shape, scale):
        return jax.random.normal(k, shape, f32) * scale

    x = nrm(ks[0], (BATCH, SEQ, D_MODEL), 1.0)
    offset = jax.random.randint(ks[1], (BATCH, 1), 0, 4096, dtype=jnp.int32)
    positions = offset + jnp.arange(SEQ, dtype=jnp.int32)[None, :]
    return {
        'x': x,
        'positions': positions,
        'norm_pre_g': 1.0 + nrm(ks[2], (L, D_MODEL), 0.02),
        'w_in': nrm(ks[3], (L, D_MODEL, D_IN), D_MODEL ** -0.5),
        'mla_q_norm_g': 1.0 + nrm(ks[4], (L, Q_LORA), 0.02),
        'mla_w_uq': nrm(ks[5], (L, Q_LORA, MLA_HEADS * (MLA_NOPE + MLA_ROPE)), Q_LORA ** -0.5),
        'mla_kv_norm_g': 1.0 + nrm(ks[6], (L, KV_LORA), 0.02),
        'mla_w_ukv': nrm(ks[7], (L, KV_LORA, MLA_HEADS * (MLA_NOPE + MLA_V)), KV_LORA ** -0.5),
        'rw_mu': jax.random.uniform(ks[8], (L, RW_SHIFT_COLS), f32),
        'rw_w0': -2.5 + nrm(ks[9], (L, RW_WIDTH), 0.5),
        'rw_w2': nrm(ks[10], (L, W_LORA, RW_WIDTH), 0.5 * W_LORA ** -0.5),
        'rw_a0': nrm(ks[11], (L, RW_WIDTH), 0.1),
        'rw_a2': nrm(ks[12], (L, A_LORA, RW_WIDTH), 0.5 * A_LORA ** -0.5),
        'rw_k_k': 0.85 + nrm(ks[13], (L, RW_WIDTH), 0.05),
        'rw_k_a': 1.0 + nrm(ks[14], (L, RW_WIDTH), 0.05),
        'rw_r_k': nrm(ks[15], (L, RW_HEADS, RW_HEAD), 0.1),
        'rw_ln_g': 1.0 + nrm(ks[16], (L, RW_WIDTH), 0.02),
        'rw_ln_b': nrm(ks[17], (L, RW_WIDTH), 0.02),
        'w_out': nrm(ks[18], (L, D_MIX, D_MODEL), D_MIX ** -0.5),
        'norm_post_g': 1.0 + nrm(ks[19], (L, D_MODEL), 0.02),
    }


def reference(x, positions, norm_pre_g, w_in, mla_q_norm_g, mla_w_uq, mla_kv_norm_g, mla_w_ukv,
              rw_mu, rw_w0, rw_w2, rw_a0, rw_a2, rw_k_k, rw_k_a, rw_r_k, rw_ln_g, rw_ln_b,
              w_out, norm_post_g):
    B, T, _ = x.shape
    f32 = jnp.float32
    cos, sin = rope_tables(positions)
    h = x
    for l in range(DEPTH):
        u = rmsnorm(h, norm_pre_g[l])
        p = u @ w_in[l]
        p_mla, p_rw, z = jnp.split(p, [MLA_COLS, MLA_COLS + RW_SHIFT_COLS], axis=-1)

        c_q, c_kv, k_r = jnp.split(p_mla, [Q_LORA, Q_LORA + KV_LORA], axis=-1)
        q = (rmsnorm(c_q, mla_q_norm_g[l]) @ mla_w_uq[l]).reshape(B, T, MLA_HEADS, MLA_NOPE + MLA_ROPE)
        q_nope, q_rope = jnp.split(q, [MLA_NOPE], axis=-1)
        kv = (rmsnorm(c_kv, mla_kv_norm_g[l]) @ mla_w_ukv[l]).reshape(B, T, MLA_HEADS, MLA_NOPE + MLA_V)
        k_nope, v_mla = jnp.split(kv, [MLA_NOPE], axis=-1)
        q_rope = apply_rope(q_rope, cos[:, :, None, :], sin[:, :, None, :])
        k_r = apply_rope(k_r, cos, sin)
        y_mla = mla_attention(q_nope, q_rope, k_nope, k_r, v_mla).reshape(B, T, MLA_WIDTH)

        ps = p_rw + (token_shift(p_rw) - p_rw) * rw_mu[l]
        r, k, v, xw, xa = jnp.split(
            ps, [RW_WIDTH, 2 * RW_WIDTH, 3 * RW_WIDTH, 3 * RW_WIDTH + W_LORA], axis=-1)
        w_log = -jax.nn.softplus(-(rw_w0[l] + jnp.tanh(xw) @ rw_w2[l]).astype(f32)) - 0.5
        decay = jnp.exp(-jnp.exp(w_log))
        a = jax.nn.sigmoid((rw_a0[l] + xa @ rw_a2[l]).astype(f32))
        kk = (k * rw_k_k[l]).astype(f32).reshape(B, T, RW_HEADS, RW_HEAD)
        kk = kk / jnp.maximum(jnp.linalg.norm(kk, axis=-1, keepdims=True), 1e-12)
        k = k.astype(f32) * (1.0 + (a - 1.0) * rw_k_a[l].astype(f32))
        heads = lambda t: t.reshape(B, T, RW_HEADS, RW_HEAD)
        r_h, k_h, v_h = heads(r.astype(f32)), heads(k), heads(v.astype(f32))
        y = wkv7_scan(r_h, heads(decay), k_h, v_h, kk, heads(a))
        mean = jnp.mean(y, axis=-1, keepdims=True)
        var = jnp.mean(jnp.square(y - mean), axis=-1, keepdims=True)
        y = ((y - mean) * lax.rsqrt(var + RW_GN_EPS)).reshape(B, T, RW_WIDTH)
        y = y * rw_ln_g[l].astype(f32) + rw_ln_b[l].astype(f32)
        bonus = jnp.sum(r_h * k_h * rw_r_k[l].astype(f32), axis=-1, keepdims=True) * v_h
        y_rw = (y + bonus.reshape(B, T, RW_WIDTH)).astype(x.dtype)

        y_cat = jnp.concatenate([y_mla, y_rw], axis=-1) * jax.nn.silu(z)
        out = y_cat @ w_out[l]
        h = h + rmsnorm(out, norm_post_g[l])
    return h
```

```cpp
#include <hip/hip_runtime.h>
#include <hip/hip_cooperative_groups.h>
#include <cstdio>
namespace cg = cooperative_groups;

#define DI __device__ __forceinline__
typedef float f32x16 __attribute__((ext_vector_type(16)));
typedef float f32x2 __attribute__((ext_vector_type(2)));
typedef short s16x4 __attribute__((ext_vector_type(4)));
typedef unsigned u32x2 __attribute__((ext_vector_type(2)));
typedef __bf16 bf16x2_t __attribute__((ext_vector_type(2)));

constexpr int NB = 32, T = 2048, M = NB * T, D = 1024, DIN = 3136, NP = 3328;
constexpr int C_CKV = 256, C_KR = 384, C_R = 512, C_K = 1024, C_V = 1536, C_XW = 2048, C_XA = 2112, C_Z = 2304;
constexpr float NORM_EPS = 1e-6f, GN_EPS = 64e-5f;
constexpr float QSCALE = 0.07216878364870322f * 1.4426950408889634f;

constexpr size_t OFF_WIN  = 0;
constexpr size_t OFF_WUQ  = OFF_WIN + (size_t)NP * 1024 * 2;
constexpr size_t OFF_WKN  = OFF_WUQ + (size_t)768 * 256 * 2;
constexpr size_t OFF_WV   = OFF_WKN + (size_t)512 * 256 * 2;
constexpr size_t OFF_WOUT = OFF_WV + (size_t)512 * 256 * 2;
constexpr size_t OFF_SS   = OFF_WOUT + (size_t)1024 * 1024 * 2;
constexpr size_t OFF_ROPE = OFF_SS + (size_t)3 * M * 4;
constexpr size_t OFF_U    = OFF_ROPE + (size_t)2 * M * 32 * 4;
constexpr size_t OFF_P    = OFF_U + (size_t)M * 1024 * 2;
constexpr size_t OFF_Q    = OFF_P + (size_t)M * NP * 2;
constexpr size_t OFF_K    = OFF_Q + (size_t)128 * 2048 * 192 * 2;
constexpr size_t OFF_VT   = OFF_K + (size_t)128 * 2048 * 192 * 2;
constexpr size_t OFF_OUT  = OFF_VT + (size_t)128 * 128 * 2048 * 2;
constexpr size_t WS_END   = OFF_OUT + (size_t)M * 1024 * 2;
constexpr int LDS_BYTES = 128 * 1024;

DI unsigned pk_bf16(float a, float b) { f32x2 f = {a, b}; bf16x2_t v = __builtin_convertvector(f, bf16x2_t); return __builtin_bit_cast(unsigned, v); }
DI float bf_lo(unsigned u) { return __uint_as_float(u << 16); }
DI float bf_hi(unsigned u) { return __uint_as_float(u & 0xffff0000u); }
template <int CTRL> DI float dppf(float v) { return __builtin_bit_cast(float, __builtin_amdgcn_update_dpp(0, __builtin_bit_cast(int, v), CTRL, 0xF, 0xF, true)); }
DI float sum8(float v) { v += dppf<0xB1>(v); v += dppf<0x4E>(v); v += dppf<0x141>(v); return v; }
DI float sum16(float v) { v = sum8(v); v += dppf<0x140>(v); return v; }
DI int ptid(int wid_s) { int l = __builtin_amdgcn_mbcnt_hi(~0u, __builtin_amdgcn_mbcnt_lo(~0u, 0u)); asm volatile("" : "+v"(l)); return (wid_s << 6) | l; }
DI float silu(float z) { return z / (1.0f + __expf(-z)); }

namespace pg8 {
#define PG8_LAS __attribute__((address_space(3)))
typedef unsigned short bf16_t;
typedef short bf16x8 __attribute__((ext_vector_type(8)));
typedef float f32x4 __attribute__((ext_vector_type(4)));
typedef unsigned u32x4 __attribute__((ext_vector_type(4)));
constexpr int BM = 256, BK = 64, HALF = 128, HTB = HALF * BK * 2  , STAGE_BYTES = 8 * HTB, NXCD = 8, WGM = 8;

__host__ __device__ __forceinline__ int lds_byte(int r, int c) { const int st = (r >> 4) * 2 + (c >> 5), rr = r & 15, cc = c & 31, ob = rr * 64 + cc * 2; return st * 1024 + (ob ^ (((ob >> 9) & 1) << 5)); }
__host__ __device__ __forceinline__ void stage_rc(int b, int& R, int& C) { const int st = b / 1024, sb = b % 1024, swz = sb ^ (((sb >> 9) & 1) << 5); R = (st >> 1) * 16 + swz / 64; C = (st & 1) * 32 + (swz % 64) / 2; }
__host__ __device__ __forceinline__ int perm32(int rho) { const int n = rho >> 4, i = rho & 15; return 8 * (i >> 2) + 4 * n + (i & 3); }

struct Unit { int pm, pn; };
struct Gemm { const bf16_t* A; const bf16_t* Bt; int M, N, K, lda, ldb; };

struct StaticOrder {
    int nM, nN, nwg, G, c;
    __host__ __device__ void init(int M, int N, int G_, int c_) { nM = M / BM; nN = N / BM; nwg = nM * nN; G = G_; c = c_; }
    __host__ __device__ bool next(int i, Unit& u) const {
        const long L = (long)i * G + c; if (L >= nwg) return false;
        int wgid = (int)L; { const int q = nwg / NXCD, r = nwg % NXCD, xcd = wgid % NXCD, off = wgid / NXCD; wgid = (xcd < r ? xcd * (q + 1) : r * (q + 1) + (xcd - r) * q) + off; }
        const int nig = WGM * nN, gid = wgid / nig, fm = gid * WGM, gsz = (nM - fm) < WGM ? (nM - fm) : WGM;
        u.pm = fm + ((wgid % nig) % gsz); u.pn = (wgid % nig) / gsz; return true;
    }
    __device__ __forceinline__ void a_ready(const Unit&) const {}
    __device__ __forceinline__ void done(const Unit&) const {}
};
DI u32x4 pack8(f32x4 v0, f32x4 v1) { u32x4 w; w.x = pk_bf16(v0[0], v0[1]); w.y = pk_bf16(v0[2], v0[3]); w.z = pk_bf16(v1[0], v1[1]); w.w = pk_bf16(v1[2], v1[3]); return w; }
DI float dot8(f32x4 a, f32x4 b) { return a[0] * a[0] + a[1] * a[1] + a[2] * a[2] + a[3] * a[3] + b[0] * b[0] + b[1] * b[1] + b[2] * b[2] + b[3] * b[3]; }

template <int MODE> struct EpiStoreSS {
    static constexpr bool PERM = true, AFTER_DRAIN = false;
    bf16_t* O; int ldc; float* ss0; float* ss1;
    DI void operator()(const f32x4 (&acc)[2][2][4][2], const Unit& u, int wr, int wc, int fr, int fq) const {
        asm volatile("" : "+v"(fr), "+v"(fq));
        const int row0 = u.pm * BM + wr * 64 + fr, col0 = u.pn * BM + wc * 32 + 8 * fq;
        const bool want = (MODE == 1) || (u.pn <= 1);
#pragma unroll
        for (int ai = 0; ai < 2; ++ai)
#pragma unroll
            for (int m = 0; m < 4; ++m) { __builtin_amdgcn_sched_barrier(0);
                const int row = row0 + ai * HALF + m * 16; bf16_t* rowp = O + (size_t)row * ldc + col0; float ss = 0.f;
#pragma unroll
                for (int bj = 0; bj < 2; ++bj) { const f32x4 v0 = acc[ai][bj][m][0], v1 = acc[ai][bj][m][1];
                    *(u32x4*)(rowp + bj * HALF) = pack8(v0, v1);
                    if (MODE == 1 || u.pn == 0 || bj == 0) ss += dot8(v0, v1); }
                if (want) { ss += __shfl_xor(ss, 16); ss += __shfl_xor(ss, 32);
                    if (fq == 0) atomicAdd(((MODE == 1 || u.pn == 0) ? ss0 : ss1) + row, ss); }
            }
    }
};
struct EpiQ {
    static constexpr bool PERM = true, AFTER_DRAIN = false;
    bf16_t* Q; const float* ssq; const float* cosT; const float* sinT;
    DI void operator()(const f32x4 (&acc)[2][2][4][2], const Unit& u, int wr, int wc, int fr, int fq) const {
        asm volatile("" : "+v"(fr), "+v"(fq));
        const int row0 = u.pm * BM + wr * 64 + fr, col0 = u.pn * BM + wc * 32 + 8 * fq;
#pragma unroll
        for (int ai = 0; ai < 2; ++ai)
#pragma unroll
            for (int m = 0; m < 4; ++m) { __builtin_amdgcn_sched_barrier(0);
                const int row = row0 + ai * HALF + m * 16, b = row >> 11, t = row & 2047;
                const float rs = rsqrtf(ssq[row] * (1.0f / 256.0f) + NORM_EPS) * QSCALE;
#pragma unroll
                for (int bj = 0; bj < 2; ++bj) { const int c = col0 + bj * HALF, h = c / 192, d0 = c - h * 192;
                    f32x4 v0 = acc[ai][bj][m][0] * rs, v1 = acc[ai][bj][m][1] * rs;
                    if (d0 >= 128) { const int g = (d0 - 128) >> 3;
                        const f32x4 cs = *(const f32x4*)(cosT + (size_t)row * 32 + 4 * g), sn = *(const f32x4*)(sinT + (size_t)row * 32 + 4 * g);
                        const f32x4 o1 = v0 * cs - v1 * sn, o2 = v1 * cs + v0 * sn; v0 = o1; v1 = o2; }
                    *(u32x4*)(Q + ((size_t)(b * 4 + h) * 2048 + t) * 192 + d0) = pack8(v0, v1); }
            }
    }
};
struct EpiKN {
    static constexpr bool PERM = true, AFTER_DRAIN = false;
    bf16_t* Kc; const float* sskv;
    DI void operator()(const f32x4 (&acc)[2][2][4][2], const Unit& u, int wr, int wc, int fr, int fq) const {
        asm volatile("" : "+v"(fr), "+v"(fq));
        const int row0 = u.pm * BM + wr * 64 + fr, col0 = u.pn * BM + wc * 32 + 8 * fq;
#pragma unroll
        for (int ai = 0; ai < 2; ++ai)
#pragma unroll
            for (int m = 0; m < 4; ++m) { __builtin_amdgcn_sched_barrier(0);
                const int row = row0 + ai * HALF + m * 16, b = row >> 11, t = row & 2047;
                const float rs = rsqrtf(sskv[row] * (1.0f / 128.0f) + NORM_EPS);
#pragma unroll
                for (int bj = 0; bj < 2; ++bj) { const int c = col0 + bj * HALF, h = c >> 7, d0 = c & 127;
                    *(u32x4*)(Kc + ((size_t)(b * 4 + h) * 2048 + t) * 192 + d0) = pack8(acc[ai][bj][m][0] * rs, acc[ai][bj][m][1] * rs); }
            }
    }
};
struct EpiVT {
    static constexpr bool PERM = true, AFTER_DRAIN = false;
    bf16_t* VT; const float* sskv;
    DI void operator()(const f32x4 (&acc)[2][2][4][2], const Unit& u, int wr, int wc, int fr, int fq) const {
        asm volatile("" : "+v"(fr), "+v"(fq));
        const int row0 = u.pm * BM + wr * 64 + fr, col0 = u.pn * BM + wc * 32 + 8 * fq;
        f32x4 s0[2], s1[2];
#pragma unroll
        for (int bj = 0; bj < 2; ++bj) { const f32x4 a = *(const f32x4*)(sskv + col0 + bj * HALF), c = *(const f32x4*)(sskv + col0 + bj * HALF + 4);
#pragma unroll
            for (int j = 0; j < 4; ++j) { s0[bj][j] = rsqrtf(a[j] * (1.0f / 128.0f) + NORM_EPS); s1[bj][j] = rsqrtf(c[j] * (1.0f / 128.0f) + NORM_EPS); } }
#pragma unroll
        for (int ai = 0; ai < 2; ++ai)
#pragma unroll
            for (int m = 0; m < 4; ++m) { __builtin_amdgcn_sched_barrier(0);
                const int row = row0 + ai * HALF + m * 16, h = row >> 7, dv = row & 127;
#pragma unroll
                for (int bj = 0; bj < 2; ++bj) { const int tok = col0 + bj * HALF, b = tok >> 11, t = tok & 2047;
                    *(u32x4*)(VT + ((size_t)(b * 4 + h) * 128 + dv) * 2048 + t) = pack8(acc[ai][bj][m][0] * s0[bj], acc[ai][bj][m][1] * s1[bj]); }
            }
    }
};

template <class Epi, class Sched, bool STAMP = false>
__device__ __forceinline__ void gemm_phase(PG8_LAS unsigned char* lds, const Gemm g, const Sched& S, const Epi& E, unsigned long long* stamps, int wid_s) {
    const int tid = ptid(wid_s), wid = wid_s, lane = tid & 63, wr = wid >> 2, wc = wid & 3, fr = lane & 15, fq = lane >> 4;
    const int K = g.K, nt = K / BK;
    int ts_lo = 0, ts_hi = 0, nts = 0; const unsigned long long rt_entry = STAMP ? (unsigned long long)wall_clock64() : 0ull;
#define PG8_STAMP() do { if (STAMP && wid == 0 && nts < 64) { const unsigned long long _c = (unsigned long long)clock64(); \
        ts_lo = (lane == nts) ? (int)(unsigned)_c : ts_lo; ts_hi = (lane == nts) ? (int)(unsigned)(_c >> 32) : ts_hi; ++nts; } } while (0)
    PG8_STAMP();
    unsigned voffA[2], voffB[2];
#pragma unroll
    for (int i = 0; i < 2; ++i) { int R, C; stage_rc(tid * 16 + i * 8192, R, C); const int Rb = Epi::PERM ? ((R & ~31) + perm32(R & 31)) : R;
        voffA[i] = (unsigned)(R * g.lda + C) * 2u; voffB[i] = (unsigned)(Rb * g.ldb + C) * 2u; }
    const size_t kstep = (size_t)(BK * 2);
    const size_t hsA = (size_t)HALF * g.lda * 2, hsB = (size_t)HALF * g.ldb * 2;
    const size_t tsA = 2 * hsA, tsB = 2 * hsB;
    const unsigned ldsw = (unsigned)wid * 1024u;
    const int aoff = lds_byte(wr * 64 + fr, fq * 8), boff = lds_byte(wc * 32 + fr, fq * 8);
#define PG8_SA(b, h) (((b) * 2 + (h)) * HTB)
#define PG8_SB(b, h) ((4 + (b) * 2 + (h)) * HTB)
#define PG8_STAGE(bufoff, gbase, voff) do { _Pragma("unroll") for (int _i = 0; _i < 2; ++_i) \
        __builtin_amdgcn_global_load_lds((const unsigned*)((const char*)(gbase) + (voff)[_i]), (PG8_LAS unsigned*)(lds + (bufoff) + ldsw + _i * 8192), 16, 0, 0); } while (0)
#define PG8_LDA(dst, b, h) do { _Pragma("unroll") for (int m = 0; m < 4; ++m) _Pragma("unroll") for (int k = 0; k < 2; ++k) dst[m][k] = *(const PG8_LAS bf16x8*)(lds + PG8_SA(b, h) + aoff + m * 2048 + k * 1024); } while (0)
#define PG8_LDB(dst, b, h) do { _Pragma("unroll") for (int n = 0; n < 2; ++n) _Pragma("unroll") for (int k = 0; k < 2; ++k) dst[n][k] = *(const PG8_LAS bf16x8*)(lds + PG8_SB(b, h) + boff + n * 2048 + k * 1024); } while (0)
#define PG8_MMA(ai, bj, At, Bt) do { __builtin_amdgcn_s_setprio(1); _Pragma("unroll") for (int m = 0; m < 4; ++m) _Pragma("unroll") for (int n = 0; n < 2; ++n) _Pragma("unroll") for (int k = 0; k < 2; ++k) \
        acc[ai][bj][m][n] = __builtin_amdgcn_mfma_f32_16x16x32_bf16(Bt[n][k], At[m][k], acc[ai][bj][m][n], 0, 0, 0); __builtin_amdgcn_s_setprio(0); } while (0)
#define PG8_WAIT_V(n) asm volatile("s_waitcnt vmcnt(" #n ")" ::: "memory")
#define PG8_WAIT_L(n) asm volatile("s_waitcnt lgkmcnt(" #n ")" ::: "memory")
#define PG8_BAR __builtin_amdgcn_s_barrier()
#define PG8_SCHED __builtin_amdgcn_sched_barrier(0)
    Unit cur, nxt; int ui = 0;
    if (!S.next(0, cur)) return;
    f32x4 acc[2][2][4][2];
#pragma unroll
    for (int a = 0; a < 2; ++a)
#pragma unroll
        for (int b = 0; b < 2; ++b)
#pragma unroll
            for (int m = 0; m < 4; ++m)
#pragma unroll
                for (int n = 0; n < 2; ++n) acc[a][b][m][n] = (f32x4){0.f, 0.f, 0.f, 0.f};
    bf16x8 At[4][2], B0[2][2], B1[2][2];
    const char* cA = (const char*)g.A + (size_t)cur.pm * tsA; const char* cB = (const char*)g.Bt + (size_t)cur.pn * tsB;
    S.a_ready(cur);
    PG8_STAGE(PG8_SB(0, 0), cB, voffB); PG8_STAGE(PG8_SA(0, 0), cA, voffA); PG8_STAGE(PG8_SB(0, 1), cB + hsB, voffB); PG8_STAGE(PG8_SA(0, 1), cA + hsA, voffA);
    if (wr == 1) PG8_BAR;
    PG8_WAIT_V(4); PG8_BAR;
    PG8_STAGE(PG8_SB(1, 0), cB + kstep, voffB); PG8_STAGE(PG8_SA(1, 0), cA + kstep, voffA); PG8_STAGE(PG8_SB(1, 1), cB + hsB + kstep, voffB);
    PG8_WAIT_V(6); PG8_BAR;
    PG8_STAMP();
    for (;;) {
        const bool has_next = S.next(ui + 1, nxt);
        const char* nA = has_next ? (const char*)g.A + (size_t)nxt.pm * tsA : cA; const char* nB = has_next ? (const char*)g.Bt + (size_t)nxt.pn * tsB : cB;
        for (int t = 0; t < nt; t += 2) {
            const bool last = (t == nt - 2);
            const char* a1 = cA + (size_t)(t + 1) * kstep;
            const char* a2 = last ? nA : cA + (size_t)(t + 2) * kstep; const char* b2 = last ? nB : cB + (size_t)(t + 2) * kstep;
            const char* a3 = a2 + kstep; const char* b3 = b2 + kstep;
            if (last && has_next) S.a_ready(nxt);
            PG8_LDB(B0, 0, 0); PG8_SCHED; PG8_LDA(At, 0, 0); PG8_STAGE(PG8_SA(1, 1), a1 + hsA, voffA);
            PG8_WAIT_L(8); PG8_BAR; PG8_WAIT_L(0); PG8_MMA(0, 0, At, B0); PG8_BAR; PG8_SCHED;
            PG8_LDB(B1, 0, 1); PG8_STAGE(PG8_SB(0, 0), b2, voffB);
            PG8_BAR; PG8_WAIT_L(0); PG8_MMA(0, 1, At, B1); PG8_BAR;
            PG8_LDA(At, 0, 1); PG8_STAGE(PG8_SA(0, 0), a2, voffA);
            PG8_BAR; PG8_WAIT_L(0); PG8_MMA(1, 0, At, B0); PG8_BAR; PG8_SCHED;
            PG8_STAGE(PG8_SB(0, 1), b2 + hsB, voffB);
            PG8_WAIT_V(6); PG8_BAR; PG8_MMA(1, 1, At, B1); PG8_BAR;
            PG8_LDB(B0, 1, 0); PG8_SCHED; PG8_LDA(At, 1, 0); PG8_STAGE(PG8_SA(0, 1), a2 + hsA, voffA);
            PG8_WAIT_L(8); PG8_BAR; PG8_WAIT_L(0); PG8_MMA(0, 0, At, B0); PG8_BAR; PG8_SCHED;
            PG8_LDB(B1, 1, 1); PG8_STAGE(PG8_SB(1, 0), b3, voffB);
            PG8_BAR; PG8_WAIT_L(0); PG8_MMA(0, 1, At, B1); PG8_BAR;
            PG8_LDA(At, 1, 1); PG8_STAGE(PG8_SA(1, 0), a3, voffA);
            PG8_BAR; PG8_WAIT_L(0); PG8_MMA(1, 0, At, B0); PG8_BAR; PG8_SCHED;
            PG8_STAGE(PG8_SB(1, 1), b3 + hsB, voffB);
            PG8_WAIT_V(6); PG8_BAR; PG8_MMA(1, 1, At, B1); PG8_BAR;
        }
        PG8_STAMP();
        if constexpr (!Epi::AFTER_DRAIN) { E(acc, cur, wr, wc, fr, fq); S.done(cur); }
        PG8_STAMP();
        if (!has_next) break;
#pragma unroll
        for (int a = 0; a < 2; ++a)
#pragma unroll
            for (int b = 0; b < 2; ++b)
#pragma unroll
                for (int m = 0; m < 4; ++m)
#pragma unroll
                    for (int n = 0; n < 2; ++n) acc[a][b][m][n] = (f32x4){0.f, 0.f, 0.f, 0.f};
        cur = nxt; cA = nA; cB = nB; ++ui;
    }
    PG8_WAIT_V(0);
    if (wr == 0) PG8_BAR;
    PG8_BAR;
    if constexpr (Epi::AFTER_DRAIN) { E.fused(acc, cur, wr, wc, fr, fq, lds, wid, lane); S.done(cur); }
    PG8_STAMP();
    if (STAMP && wid == 0) { stamps[lane] = lane < nts ? (((unsigned long long)(unsigned)ts_hi << 32) | (unsigned)ts_lo) : 0ull;
        if (lane == 62) stamps[62] = rt_entry; if (lane == 63) stamps[63] = (unsigned long long)wall_clock64(); }
#undef PG8_STAMP
#undef PG8_SA
#undef PG8_SB
#undef PG8_STAGE
#undef PG8_LDA
#undef PG8_LDB
#undef PG8_MMA
#undef PG8_WAIT_V
#undef PG8_WAIT_L
#undef PG8_BAR
#undef PG8_SCHED
}
}
using pg8::bf16_t; using pg8::bf16x8; using pg8::f32x4; using pg8::u32x4;
typedef __attribute__((address_space(3))) unsigned char lds_u8;

struct Params {
    const float* x; const int* pos; const float* g_pre; const float* w_in; const float* g_q; const float* w_uq; const float* g_kv; const float* w_ukv;
    const float* mu; const float* w0; const float* w2; const float* a0; const float* a2; const float* k_k; const float* k_a; const float* r_k;
    const float* ln_g; const float* ln_b; const float* w_out; const float* g_post; float* out; unsigned char* ws;
};

DI int map_in(int n) {
    if (n < 448) return n;
    if (n < 512) return -1;
    if (n < 2048) return n - 64;
    if (n < 2176) return n - 64;
    if (n < 2304) return -1;
    return n - 192;
}
DI int map_q(int n) {
    const int h = n / 192, d = n - h * 192;
    if (d < 128) return n;
    const int j = d - 128, g = j >> 3, i = j & 7, orig = (i < 4) ? (4 * g + i) : (32 + 4 * g + (i - 4));
    return h * 192 + 128 + orig;
}
DI void wconv_tile(int tid, float* tl, int mode, int tn, int tk, const float* src, int ld, int Ksrc, int Kdst, const float* gain, bf16_t* dst) {
    const int n0 = tn * 64, k0 = tk * 64;
#pragma unroll
    for (int e = 0; e < 8; ++e) { const int idx = tid + 512 * e, kk = idx >> 6, nn = idx & 63, n = n0 + nn, k = k0 + kk;
        int sc;
        if (mode == 0) sc = map_in(n); else if (mode == 1) sc = map_q(n); else if (mode == 2) sc = (n >> 7) * 256 + (n & 127); else if (mode == 3) sc = (n >> 7) * 256 + 128 + (n & 127); else sc = n;
        float v = 0.f;
        if (k < Ksrc && sc >= 0) { v = src[(size_t)k * ld + sc]; if (gain) v *= gain[k]; }
        tl[kk * 65 + nn] = v; }
    __syncthreads();
#pragma unroll
    for (int e = 0; e < 8; ++e) { const int idx = tid + 512 * e, nn = idx >> 6, kk = idx & 63;
        const float v = tl[kk * 65 + nn];
        dst[(size_t)(n0 + nn) * Kdst + k0 + kk] = (bf16_t)(pk_bf16(v, 0.f) & 0xffffu); }
    __syncthreads();
}
DI void phase0(const Params& p, float* tl, int wid_s) {
    const int tid = ptid(wid_s), lane = tid & 63, bid = blockIdx.x, G = gridDim.x;
    unsigned char* ws = p.ws;
    for (int i = bid; i < 832 + 48 + 32 + 32 + 256; i += G) {
        if (i < 832) wconv_tile(tid, tl, 0, i >> 4, i & 15, p.w_in, DIN, 1024, 1024, nullptr, (bf16_t*)(ws + OFF_WIN));
        else if (i < 880) { const int j = i - 832; wconv_tile(tid, tl, 1, j >> 2, j & 3, p.w_uq, 768, 256, 256, p.g_q, (bf16_t*)(ws + OFF_WUQ)); }
        else if (i < 912) { const int j = i - 880; wconv_tile(tid, tl, 2, j >> 2, j & 3, p.w_ukv, 1024, 128, 256, p.g_kv, (bf16_t*)(ws + OFF_WKN)); }
        else if (i < 944) { const int j = i - 912; wconv_tile(tid, tl, 3, j >> 2, j & 3, p.w_ukv, 1024, 128, 256, p.g_kv, (bf16_t*)(ws + OFF_WV)); }
        else { const int j = i - 944; wconv_tile(tid, tl, 4, j >> 4, j & 15, p.w_out, 1024, 1024, 1024, nullptr, (bf16_t*)(ws + OFF_WOUT)); }
    }
    { float* ss = (float*)(ws + OFF_SS); for (int i = bid * 512 + tid; i < 3 * M; i += G * 512) ss[i] = 0.f; }
    { float* cs = (float*)(ws + OFF_ROPE); float* sn = cs + (size_t)M * 32;
      for (int i = bid * 512 + tid; i < M * 32; i += G * 512) { const int m = i >> 5, j = i & 31;
          const float inv = powf(10000.0f, -(float)(2 * j) * (1.0f / 64.0f)); const float ang = (float)p.pos[m] * inv; float s, c; sincosf(ang, &s, &c); cs[i] = c; sn[i] = s; } }
    { bf16_t* U = (bf16_t*)(ws + OFF_U); const int gw = bid * 8 + (tid >> 6), nw = G * 8;
      f32x4 g[4];
#pragma unroll
      for (int i = 0; i < 4; ++i) g[i] = *(const f32x4*)(p.g_pre + (lane + 64 * i) * 4);
      for (int row = gw; row < M; row += nw) { const float* xr = p.x + (size_t)row * D; f32x4 v[4]; float ss = 0.f;
#pragma unroll
          for (int i = 0; i < 4; ++i) { v[i] = *(const f32x4*)(xr + (lane + 64 * i) * 4); ss += v[i][0] * v[i][0] + v[i][1] * v[i][1] + v[i][2] * v[i][2] + v[i][3] * v[i][3]; }
#pragma unroll
          for (int o = 1; o < 64; o <<= 1) ss += __shfl_xor(ss, o);
          const float rs = rsqrtf(ss * (1.0f / 1024.0f) + NORM_EPS);
#pragma unroll
          for (int i = 0; i < 4; ++i) { u32x2 w; w.x = pk_bf16(v[i][0] * rs * g[i][0], v[i][1] * rs * g[i][1]); w.y = pk_bf16(v[i][2] * rs * g[i][2], v[i][3] * rs * g[i][3]);
              *(u32x2*)(U + (size_t)row * D + (lane + 64 * i) * 4) = w; } } }
}
DI void phase_krope(const Params& p, int wid_s) {
    const unsigned char* ws = p.ws; const bf16_t* P = (const bf16_t*)(ws + OFF_P); bf16_t* Kc = (bf16_t*)(p.ws + OFF_K);
    const float* cs = (const float*)(ws + OFF_ROPE); const float* sn = cs + (size_t)M * 32;
    for (int i = blockIdx.x * 512 + ptid(wid_s); i < M * 8; i += gridDim.x * 512) { const int m = i >> 3, g = i & 7, b = m >> 11, t = m & 2047;
        const u32x2 a = *(const u32x2*)(P + (size_t)m * NP + C_KR + 4 * g), c = *(const u32x2*)(P + (size_t)m * NP + C_KR + 32 + 4 * g);
        const f32x4 x1 = {bf_lo(a.x), bf_hi(a.x), bf_lo(a.y), bf_hi(a.y)}, x2 = {bf_lo(c.x), bf_hi(c.x), bf_lo(c.y), bf_hi(c.y)};
        const f32x4 co = *(const f32x4*)(cs + (size_t)m * 32 + 4 * g), si = *(const f32x4*)(sn + (size_t)m * 32 + 4 * g);
        const u32x4 w = pg8::pack8(x1 * co - x2 * si, x2 * co + x1 * si);
#pragma unroll
        for (int h = 0; h < 4; ++h) *(u32x4*)(Kc + ((size_t)(b * 4 + h) * 2048 + t) * 192 + 128 + 8 * g) = w; }
}
DI void phase_final(const Params& p, int wid_s) {
    const int tid = ptid(wid_s), lane = tid & 63; const bf16_t* O = (const bf16_t*)(p.ws + OFF_OUT); const float* sso = (const float*)(p.ws + OFF_SS) + 2 * M;
    const int gw = blockIdx.x * 8 + (tid >> 6), nw = gridDim.x * 8;
    f32x4 g[4];
#pragma unroll
    for (int i = 0; i < 4; ++i) g[i] = *(const f32x4*)(p.g_post + (lane + 64 * i) * 4);
    for (int row = gw; row < M; row += nw) { const float rs = rsqrtf(sso[row] * (1.0f / 1024.0f) + NORM_EPS);
#pragma unroll
        for (int i = 0; i < 4; ++i) { const size_t o = (size_t)row * D + (lane + 64 * i) * 4; const f32x4 xv = *(const f32x4*)(p.x + o); const u32x2 ov = *(const u32x2*)(O + o);
            f32x4 r; r[0] = xv[0] + bf_lo(ov.x) * rs * g[i][0]; r[1] = xv[1] + bf_hi(ov.x) * rs * g[i][1]; r[2] = xv[2] + bf_lo(ov.y) * rs * g[i][2]; r[3] = xv[3] + bf_hi(ov.y) * rs * g[i][3];
            *(f32x4*)(p.out + o) = r; } }
}

#define MFMA32(a, b, c) __builtin_amdgcn_mfma_f32_32x32x16_bf16((a), (b), (c), 0, 0, 0)
constexpr int KROW = 400, VROW = 136, KT_BYTES = 64 * KROW, VT_BYTES = 128 * VROW;
constexpr int ATT_K0 = 0, ATT_V0 = 2 * KT_BYTES;

DI void attn_item(lds_u8* lds, const Params& p, int bh, int qb, int wid_s) {
    const unsigned char* ws = p.ws;
    const bf16_t* Qg = (const bf16_t*)(ws + OFF_Q) + (size_t)bh * 2048 * 192;
    const unsigned char* Kg = ws + OFF_K + (size_t)bh * 2048 * 384;
    const unsigned char* Vg = ws + OFF_VT + (size_t)bh * 128 * 4096;
    const bf16_t* P = (const bf16_t*)(ws + OFF_P); bf16_t* Y = (bf16_t*)(p.ws + OFF_U);
    const int tid = ptid(wid_s), lane = tid & 63, w = wid_s, r = lane & 31, hh = lane >> 5;
    const int b = bh >> 2, h = bh & 3, qrow = qb * 256 + 32 * w + r;
    const int nkt = 4 * (qb + 1), my_last = qb * 4 + (w >> 1);
    int kdst[3], vsrc[2], vdst[2];
#pragma unroll
    for (int j = 0; j < 3; ++j) { const int c = tid + 512 * j, key = c / 24, part = c - key * 24; kdst[j] = key * KROW + part * 16; }
#pragma unroll
    for (int j = 0; j < 2; ++j) { const int c = tid + 512 * j, dv = c >> 3, part = c & 7; vsrc[j] = dv * 4096 + part * 16; vdst[j] = dv * VROW + part * 16; }
    bf16x8 qf[12];
#pragma unroll
    for (int s = 0; s < 12; ++s) qf[s] = *(const bf16x8*)(Qg + (size_t)qrow * 192 + 16 * s + 8 * hh);
    u32x4 kst[3], vst[2];
#pragma unroll
    for (int j = 0; j < 3; ++j) kst[j] = *(const u32x4*)(Kg + (size_t)(tid + 512 * j) * 16);
#pragma unroll
    for (int j = 0; j < 2; ++j) vst[j] = *(const u32x4*)(Vg + vsrc[j]);
#pragma unroll
    for (int j = 0; j < 3; ++j) *(u32x4*)(lds + ATT_K0 + kdst[j]) = kst[j];
#pragma unroll
    for (int j = 0; j < 2; ++j) { *(u32x2*)(lds + ATT_V0 + vdst[j]) = (u32x2){vst[j].x, vst[j].y}; *(u32x2*)(lds + ATT_V0 + vdst[j] + 8) = (u32x2){vst[j].z, vst[j].w}; }
    __syncthreads();
    f32x16 o[4];
#pragma unroll
    for (int dt = 0; dt < 4; ++dt)
#pragma unroll
        for (int i = 0; i < 16; ++i) o[dt][i] = 0.f;
    float mrow = -1e30f, lsum = 0.f;
    for (int kt = 0; kt < nkt; ++kt) {
        const int cur = kt & 1, nxt = cur ^ 1;
        if (kt + 1 < nkt) {
#pragma unroll
            for (int j = 0; j < 3; ++j) kst[j] = *(const u32x4*)(Kg + (size_t)(kt + 1) * 64 * 384 + (size_t)(tid + 512 * j) * 16);
#pragma unroll
            for (int j = 0; j < 2; ++j) vst[j] = *(const u32x4*)(Vg + (kt + 1) * 128 + vsrc[j]);
        }
        if (kt <= my_last) {
            const lds_u8* kb = lds + ATT_K0 + cur * KT_BYTES; const lds_u8* vb = lds + ATT_V0 + cur * VT_BYTES;
            f32x16 st[2];
#pragma unroll
            for (int sub = 0; sub < 2; ++sub) {
#pragma unroll
                for (int i = 0; i < 16; ++i) st[sub][i] = 0.f;
#pragma unroll
                for (int s = 0; s < 12; ++s) { const bf16x8 a = *(const __attribute__((address_space(3))) bf16x8*)(kb + (sub * 32 + r) * KROW + (16 * s + 8 * hh) * 2); st[sub] = MFMA32(a, qf[s], st[sub]); }
            }
            if (kt == my_last) {
#pragma unroll
                for (int sub = 0; sub < 2; ++sub)
#pragma unroll
                    for (int i = 0; i < 16; ++i) { const int key = kt * 64 + sub * 32 + (i & 3) + 8 * (i >> 2) + 4 * hh; if (key > qrow) st[sub][i] = -1e30f; }
            }
            float mx = st[0][0];
#pragma unroll
            for (int sub = 0; sub < 2; ++sub)
#pragma unroll
                for (int i = 0; i < 16; ++i) mx = fmaxf(mx, st[sub][i]);
            mx = fmaxf(mx, __shfl_xor(mx, 32));
            const float mnew = fmaxf(mrow, mx), alpha = __builtin_amdgcn_exp2f(mrow - mnew);
            mrow = mnew;
            float ps = 0.f;
#pragma unroll
            for (int sub = 0; sub < 2; ++sub)
#pragma unroll
                for (int i = 0; i < 16; ++i) { st[sub][i] = __builtin_amdgcn_exp2f(st[sub][i] - mnew); ps += st[sub][i]; }
            lsum = lsum * alpha + ps;
#pragma unroll
            for (int dt = 0; dt < 4; ++dt)
#pragma unroll
                for (int i = 0; i < 16; ++i) o[dt][i] *= alpha;
            bf16x8 pf[2][2];
#pragma unroll
            for (int sub = 0; sub < 2; ++sub)
#pragma unroll
                for (int s = 0; s < 2; ++s) { u32x4 q; q.x = pk_bf16(st[sub][8 * s], st[sub][8 * s + 1]); q.y = pk_bf16(st[sub][8 * s + 2], st[sub][8 * s + 3]);
                    q.z = pk_bf16(st[sub][8 * s + 4], st[sub][8 * s + 5]); q.w = pk_bf16(st[sub][8 * s + 6], st[sub][8 * s + 7]); pf[sub][s] = __builtin_bit_cast(bf16x8, q); }
#pragma unroll
            for (int dt = 0; dt < 4; ++dt)
#pragma unroll
                for (int sub = 0; sub < 2; ++sub)
#pragma unroll
                    for (int s = 0; s < 2; ++s) { const lds_u8* a0 = vb + (dt * 32 + r) * VROW + (sub * 32 + 16 * s + 4 * hh) * 2;
                        const s16x4 lo = *(const __attribute__((address_space(3))) s16x4*)a0, hi = *(const __attribute__((address_space(3))) s16x4*)(a0 + 16);
                        const bf16x8 a = __builtin_shufflevector(lo, hi, 0, 1, 2, 3, 4, 5, 6, 7);
                        o[dt] = MFMA32(a, pf[sub][s], o[dt]); }
        }
        if (kt + 1 < nkt) {
#pragma unroll
            for (int j = 0; j < 3; ++j) *(u32x4*)(lds + ATT_K0 + nxt * KT_BYTES + kdst[j]) = kst[j];
#pragma unroll
            for (int j = 0; j < 2; ++j) { *(u32x2*)(lds + ATT_V0 + nxt * VT_BYTES + vdst[j]) = (u32x2){vst[j].x, vst[j].y}; *(u32x2*)(lds + ATT_V0 + nxt * VT_BYTES + vdst[j] + 8) = (u32x2){vst[j].z, vst[j].w}; }
        }
        __syncthreads();
    }
    lsum += __shfl_xor(lsum, 32);
    const float inv = 1.0f / lsum;
    const size_t m = (size_t)b * 2048 + qrow;
#pragma unroll
    for (int dt = 0; dt < 4; ++dt)
#pragma unroll
        for (int g = 0; g < 4; ++g) { const int dv0 = dt * 32 + 8 * g + 4 * hh;
            const u32x2 zz = *(const u32x2*)(P + m * NP + C_Z + h * 128 + dv0);
            const float y0 = o[dt][4 * g] * inv * silu(bf_lo(zz.x)), y1 = o[dt][4 * g + 1] * inv * silu(bf_hi(zz.x)), y2 = o[dt][4 * g + 2] * inv * silu(bf_lo(zz.y)), y3 = o[dt][4 * g + 3] * inv * silu(bf_hi(zz.y));
            u32x2 wv; wv.x = pk_bf16(y0, y1); wv.y = pk_bf16(y2, y3);
            *(u32x2*)(Y + m * 1024 + h * 128 + dv0) = wv; }
}

constexpr int SC = 32;
constexpr int S_W = 0, S_KK = 8192, S_B = 16384, S_K = 24576, S_R = 32768, S_V = 40960, S_Y = 49152, S_A = 57344, S_XW = 65536, S_XA = S_XW + 32 * 144, S_BON = S_XA + 32 * 144;
#define LDSP(TY, ptr) ((__attribute__((address_space(3))) TY*)(ptr))

DI f32x4 ld4bf(const bf16_t* ptr) { const u32x2 a = *(const u32x2*)ptr; return (f32x4){bf_lo(a.x), bf_hi(a.x), bf_lo(a.y), bf_hi(a.y)}; }

DI void scan_unit(lds_u8* lds, const Params& p, int bh, int wid_s) {
    const bf16_t* P = (const bf16_t*)(p.ws + OFF_P); bf16_t* Y = (bf16_t*)(p.ws + OFF_U);
    const int tid = ptid(wid_s), lane = tid & 63, wv = wid_s, r = lane & 31, hh = lane >> 5;
    const int b = bh >> 3, h = bh & 7;
    const int tr = tid >> 4, c4 = (tid & 15) * 4, hc = h * 64 + c4;
    const int row = tid >> 3, cg8 = (tid & 7) * 8;
    const f32x4 mu_r = *(const f32x4*)(p.mu + hc), mu_k = *(const f32x4*)(p.mu + 512 + hc), mu_v = *(const f32x4*)(p.mu + 1024 + hc), mu_w = *(const f32x4*)(p.mu + 1536 + c4), mu_a = *(const f32x4*)(p.mu + 1600 + c4);
    const f32x4 kk_g = *(const f32x4*)(p.k_k + hc), ka_g = *(const f32x4*)(p.k_a + hc), rk_g = *(const f32x4*)(p.r_k + hc), lng = *(const f32x4*)(p.ln_g + hc), lnb = *(const f32x4*)(p.ln_b + hc);
    bf16x8 bfrag[4]; float bias = 0.f;
    if (wv < 4) { const float* Wm = (wv >> 1) ? p.a2 : p.w2; const int n = h * 64 + (wv & 1) * 32 + r; bias = ((wv >> 1) ? p.a0 : p.w0)[n];
#pragma unroll
        for (int s = 0; s < 4; ++s) { u32x4 q;
            q.x = pk_bf16(Wm[(size_t)(16 * s + 8 * hh + 0) * 512 + n], Wm[(size_t)(16 * s + 8 * hh + 1) * 512 + n]); q.y = pk_bf16(Wm[(size_t)(16 * s + 8 * hh + 2) * 512 + n], Wm[(size_t)(16 * s + 8 * hh + 3) * 512 + n]);
            q.z = pk_bf16(Wm[(size_t)(16 * s + 8 * hh + 4) * 512 + n], Wm[(size_t)(16 * s + 8 * hh + 5) * 512 + n]); q.w = pk_bf16(Wm[(size_t)(16 * s + 8 * hh + 6) * 512 + n], Wm[(size_t)(16 * s + 8 * hh + 7) * 512 + n]);
            bfrag[s] = __builtin_bit_cast(bf16x8, q); } }
    else {
#pragma unroll
        for (int s = 0; s < 4; ++s) bfrag[s] = (bf16x8){0, 0, 0, 0, 0, 0, 0, 0}; }
    float st[8];
#pragma unroll
    for (int i = 0; i < 8; ++i) st[i] = 0.f;

    for (int t0 = 0; t0 < T; t0 += SC) {
        const int t = t0 + tr; const size_t m = (size_t)b * 2048 + t; const bf16_t* pr = P + m * NP; const bool hp = t > 0;
        const f32x4 z4 = {0.f, 0.f, 0.f, 0.f};
        f32x4 cr = ld4bf(pr + C_R + hc), ck = ld4bf(pr + C_K + hc), cv = ld4bf(pr + C_V + hc), cw = ld4bf(pr + C_XW + c4), ca = ld4bf(pr + C_XA + c4);
        const f32x4 qr = hp ? ld4bf(pr - NP + C_R + hc) : z4, qk = hp ? ld4bf(pr - NP + C_K + hc) : z4, qv = hp ? ld4bf(pr - NP + C_V + hc) : z4, qw = hp ? ld4bf(pr - NP + C_XW + c4) : z4, qa = hp ? ld4bf(pr - NP + C_XA + c4) : z4;
        const f32x4 rs = cr + (qr - cr) * mu_r, ks = ck + (qk - ck) * mu_k, vs = cv + (qv - cv) * mu_v, xw = cw + (qw - cw) * mu_w, xa = ca + (qa - ca) * mu_a;
        *LDSP(f32x4, lds + S_R + (tr * 64 + c4) * 4) = rs;
        *LDSP(f32x4, lds + S_V + (tr * 64 + c4) * 4) = vs;
        { u32x2 q; q.x = pk_bf16(tanhf(xw[0]), tanhf(xw[1])); q.y = pk_bf16(tanhf(xw[2]), tanhf(xw[3])); *LDSP(u32x2, lds + S_XW + tr * 144 + c4 * 2) = q;
          u32x2 q2; q2.x = pk_bf16(xa[0], xa[1]); q2.y = pk_bf16(xa[2], xa[3]); *LDSP(u32x2, lds + S_XA + tr * 144 + c4 * 2) = q2; }
        __syncthreads();
        if (wv < 4) { f32x16 acc;
#pragma unroll
            for (int i = 0; i < 16; ++i) acc[i] = 0.f;
            const lds_u8* xb = lds + ((wv >> 1) ? S_XA : S_XW);
#pragma unroll
            for (int s = 0; s < 4; ++s) { const bf16x8 a = *LDSP(const bf16x8, xb + r * 144 + (16 * s + 8 * hh) * 2); acc = MFMA32(a, bfrag[s], acc); }
            const int n = (wv & 1) * 32 + r;
#pragma unroll
            for (int i = 0; i < 16; ++i) { const int tt = (i & 3) + 8 * (i >> 2) + 4 * hh; const float xv = acc[i] + bias; float res;
                if (wv >> 1) res = 1.0f / (1.0f + __expf(-xv));
                else { const float yv = -xv; const float sp = fmaxf(yv, 0.f) + log1pf(__expf(-fabsf(yv))); res = __expf(-__expf(-sp - 0.5f)); }
                *LDSP(float, lds + ((wv >> 1) ? S_A : S_W) + (tt * 64 + n) * 4) = res; } }
        __syncthreads();
        float bon;
        { const f32x4 a4 = *LDSP(const f32x4, lds + S_A + (tr * 64 + c4) * 4);
          f32x4 kk = ks * kk_g; float n2 = kk[0] * kk[0] + kk[1] * kk[1] + kk[2] * kk[2] + kk[3] * kk[3]; n2 = sum16(n2);
          const float invn = 1.0f / fmaxf(sqrtf(n2), 1e-12f); kk = kk * invn;
          const f32x4 bb = kk * a4, kp = ks * (1.0f + (a4 - 1.0f) * ka_g);
          const f32x4 pr3 = rs * kp * rk_g; bon = sum16(pr3[0] + pr3[1] + pr3[2] + pr3[3]);
          *LDSP(f32x4, lds + S_KK + (tr * 64 + c4) * 4) = kk; *LDSP(f32x4, lds + S_B + (tr * 64 + c4) * 4) = bb; *LDSP(f32x4, lds + S_K + (tr * 64 + c4) * 4) = kp; }
        __syncthreads();
#pragma unroll 2
        for (int s = 0; s < SC; ++s) {
            const lds_u8* base = lds + (s * 64 + cg8) * 4;
            const f32x4 w0 = *LDSP(const f32x4, base + S_W), w1 = *LDSP(const f32x4, base + S_W + 16), k0 = *LDSP(const f32x4, base + S_KK), k1 = *LDSP(const f32x4, base + S_KK + 16);
            const f32x4 b0 = *LDSP(const f32x4, base + S_B), b1 = *LDSP(const f32x4, base + S_B + 16), p0 = *LDSP(const f32x4, base + S_K), p1 = *LDSP(const f32x4, base + S_K + 16);
            const f32x4 r0 = *LDSP(const f32x4, base + S_R), r1 = *LDSP(const f32x4, base + S_R + 16);
            const float vv = *LDSP(const float, lds + S_V + (s * 64 + row) * 4);
            float dot = st[0] * k0[0] + st[1] * k0[1] + st[2] * k0[2] + st[3] * k0[3] + st[4] * k1[0] + st[5] * k1[1] + st[6] * k1[2] + st[7] * k1[3];
            const float sa = -sum8(dot);
#pragma unroll
            for (int i = 0; i < 4; ++i) { st[i] = st[i] * w0[i] + sa * b0[i] + vv * p0[i]; st[4 + i] = st[4 + i] * w1[i] + sa * b1[i] + vv * p1[i]; }
            float yv = st[0] * r0[0] + st[1] * r0[1] + st[2] * r0[2] + st[3] * r0[3] + st[4] * r1[0] + st[5] * r1[1] + st[6] * r1[2] + st[7] * r1[3];
            yv = sum8(yv);
            if ((tid & 7) == 0) *LDSP(float, lds + S_Y + (s * 64 + row) * 4) = yv;
        }
        __syncthreads();
        { const f32x4 y4 = *LDSP(const f32x4, lds + S_Y + (tr * 64 + c4) * 4);
          const float mean = sum16(y4[0] + y4[1] + y4[2] + y4[3]) * (1.0f / 64.0f);
          const f32x4 dlt = y4 - mean; const float var = sum16(dlt[0] * dlt[0] + dlt[1] * dlt[1] + dlt[2] * dlt[2] + dlt[3] * dlt[3]) * (1.0f / 64.0f);
          const float rstd = rsqrtf(var + GN_EPS);
          const f32x4 yn = dlt * rstd * lng + lnb + bon * vs;
          const f32x4 zz = ld4bf(pr + C_Z + 512 + hc);
          u32x2 q; q.x = pk_bf16(yn[0] * silu(zz[0]), yn[1] * silu(zz[1])); q.y = pk_bf16(yn[2] * silu(zz[2]), yn[3] * silu(zz[3]));
          *(u32x2*)(Y + m * 1024 + 512 + hc) = q; }
    }
}

__global__ void __launch_bounds__(512) hymba_fwd(Params p) {
    extern __shared__ __attribute__((aligned(16))) unsigned char lds_raw[];
    lds_u8* lds = (lds_u8*)lds_raw;
    cg::grid_group grid = cg::this_grid();
    unsigned char* ws = p.ws; const int G = gridDim.x, bid = blockIdx.x, wid_s = __builtin_amdgcn_readfirstlane(threadIdx.x >> 6);
    float* ss = (float*)(ws + OFF_SS);
    const float* cosT = (const float*)(ws + OFF_ROPE); const float* sinT = cosT + (size_t)M * 32;

    phase0(p, (float*)lds_raw, wid_s);
    grid.sync();
    { pg8::Gemm g{(const bf16_t*)(ws + OFF_U), (const bf16_t*)(ws + OFF_WIN), M, NP, 1024, 1024, 1024}; pg8::StaticOrder S; S.init(M, NP, G, bid);
      pg8::EpiStoreSS<0> E{(bf16_t*)(ws + OFF_P), NP, ss, ss + M};
      pg8::gemm_phase<pg8::EpiStoreSS<0>, pg8::StaticOrder>(lds, g, S, E, nullptr, wid_s); }
    grid.sync();
    { pg8::Gemm g{(const bf16_t*)(ws + OFF_P), (const bf16_t*)(ws + OFF_WUQ), M, 768, 256, NP, 256}; pg8::StaticOrder S; S.init(M, 768, G, bid);
      pg8::EpiQ E{(bf16_t*)(ws + OFF_Q), ss, cosT, sinT};
      pg8::gemm_phase<pg8::EpiQ, pg8::StaticOrder>(lds, g, S, E, nullptr, wid_s); }
    { pg8::Gemm g{(const bf16_t*)(ws + OFF_P) + C_CKV, (const bf16_t*)(ws + OFF_WKN), M, 512, 256, NP, 256}; pg8::StaticOrder S; S.init(M, 512, G, bid);
      pg8::EpiKN E{(bf16_t*)(ws + OFF_K), ss + M};
      pg8::gemm_phase<pg8::EpiKN, pg8::StaticOrder>(lds, g, S, E, nullptr, wid_s); }
    { pg8::Gemm g{(const bf16_t*)(ws + OFF_WV), (const bf16_t*)(ws + OFF_P) + C_CKV, 512, M, 256, 256, NP}; pg8::StaticOrder S; S.init(512, M, G, bid);
      pg8::EpiVT E{(bf16_t*)(ws + OFF_VT), ss + M};
      pg8::gemm_phase<pg8::EpiVT, pg8::StaticOrder>(lds, g, S, E, nullptr, wid_s); }
    phase_krope(p, wid_s);
    grid.sync();
    for (int u = bid; u < 256; u += G) scan_unit(lds, p, u, wid_s);
    __syncthreads();
    for (int pr = bid; pr < 512; pr += G) { const int bh = pr >> 2, j = pr & 3;
        attn_item(lds, p, bh, 7 - j, wid_s);
        attn_item(lds, p, bh, j, wid_s); }
    grid.sync();
    { pg8::Gemm g{(const bf16_t*)(ws + OFF_U), (const bf16_t*)(ws + OFF_WOUT), M, 1024, 1024, 1024, 1024}; pg8::StaticOrder S; S.init(M, 1024, G, bid);
      pg8::EpiStoreSS<1> E{(bf16_t*)(ws + OFF_OUT), 1024, ss + 2 * M, nullptr};
      pg8::gemm_phase<pg8::EpiStoreSS<1>, pg8::StaticOrder>(lds, g, S, E, nullptr, wid_s); }
    grid.sync();
    phase_final(p, wid_s);
}

extern "C" void kernel_launch(void* const* d_in, const int* in_sizes, int n_in, void* d_out, int out_size, void* d_ws, size_t ws_size, hipStream_t stream) {
    static int grid = 0;
    if (grid == 0) {
        if (n_in != 20 || out_size != M * D || ws_size < WS_END) { fprintf(stderr, "kernel_launch: unexpected shapes (n_in %d, out %d, ws %zu < %zu)\n", n_in, out_size, ws_size, (size_t)WS_END); grid = -1; return; }
        int dev = 0, cus = 0, per_cu = 0;
        hipGetDevice(&dev); hipDeviceGetAttribute(&cus, hipDeviceAttributeMultiprocessorCount, dev);
        if (hipFuncSetAttribute((const void*)hymba_fwd, hipFuncAttributeMaxDynamicSharedMemorySize, LDS_BYTES) != hipSuccess) { fprintf(stderr, "kernel_launch: hipFuncSetAttribute failed\n"); grid = -1; return; }
        if (hipOccupancyMaxActiveBlocksPerMultiprocessor(&per_cu, (const void*)hymba_fwd, 512, LDS_BYTES) != hipSuccess || per_cu < 1) { fprintf(stderr, "kernel_launch: occupancy query gave %d\n", per_cu); per_cu = 1; (void)hipGetLastError(); }
        grid = cus;
    }
    if (grid < 0) return;
    Params p{};
    p.x = (const float*)d_in[0]; p.pos = (const int*)d_in[1]; p.g_pre = (const float*)d_in[2]; p.w_in = (const float*)d_in[3]; p.g_q = (const float*)d_in[4]; p.w_uq = (const float*)d_in[5];
    p.g_kv = (const float*)d_in[6]; p.w_ukv = (const float*)d_in[7]; p.mu = (const float*)d_in[8]; p.w0 = (const float*)d_in[9]; p.w2 = (const float*)d_in[10]; p.a0 = (const float*)d_in[11];
    p.a2 = (const float*)d_in[12]; p.k_k = (const float*)d_in[13]; p.k_a = (const float*)d_in[14]; p.r_k = (const float*)d_in[15]; p.ln_g = (const float*)d_in[16]; p.ln_b = (const float*)d_in[17];
    p.w_out = (const float*)d_in[18]; p.g_post = (const float*)d_in[19]; p.out = (float*)d_out; p.ws = (unsigned char*)d_ws;
    void* args[] = {&p};
    hipError_t e = hipLaunchCooperativeKernel((const void*)hymba_fwd, dim3(grid), dim3(512), args, LDS_BYTES, stream);
    if (e != hipSuccess) fprintf(stderr, "kernel_launch: cooperative launch failed: %s (grid %d)\n", hipGetErrorString(e), grid);
}
```

```cpp
#include <hip/hip_runtime.h>
#include <hip/hip_cooperative_groups.h>
#include <cstdio>
namespace cg = cooperative_groups;

#define DI __device__ __forceinline__
typedef float f32x16 __attribute__((ext_vector_type(16)));
typedef float f32x2 __attribute__((ext_vector_type(2)));
typedef short s16x4 __attribute__((ext_vector_type(4)));
typedef unsigned u32x2 __attribute__((ext_vector_type(2)));
typedef __bf16 bf16x2_t __attribute__((ext_vector_type(2)));

constexpr int NB = 32, T = 2048, M = NB * T, D = 1024, DIN = 3136, NP = 3328;
constexpr int C_CKV = 256, C_KR = 384, C_R = 512, C_K = 1024, C_V = 1536, C_XW = 2048, C_XA = 2112, C_Z = 2304;
constexpr float NORM_EPS = 1e-6f, GN_EPS = 64e-5f;
constexpr float QSCALE = 0.07216878364870322f * 1.4426950408889634f;

constexpr size_t OFF_WIN  = 0;
constexpr size_t OFF_WUQ  = OFF_WIN + (size_t)NP * 1024 * 2;
constexpr size_t OFF_WKN  = OFF_WUQ + (size_t)768 * 256 * 2;
constexpr size_t OFF_WV   = OFF_WKN + (size_t)512 * 256 * 2;
constexpr size_t OFF_WOUT = OFF_WV + (size_t)512 * 256 * 2;
constexpr size_t OFF_SS   = OFF_WOUT + (size_t)1024 * 1024 * 2;
constexpr size_t OFF_ROPE = OFF_SS + (size_t)3 * M * 4;
constexpr size_t OFF_U    = OFF_ROPE + (size_t)2 * M * 32 * 4;
constexpr size_t OFF_P    = OFF_U + (size_t)M * 1024 * 2;
constexpr size_t OFF_Q    = OFF_P + (size_t)M * NP * 2;
constexpr size_t OFF_K    = OFF_Q + (size_t)128 * 2048 * 192 * 2;
constexpr size_t OFF_VT   = OFF_K + (size_t)128 * 2048 * 192 * 2;
constexpr size_t OFF_OUT  = OFF_VT + (size_t)128 * 128 * 2048 * 2;
constexpr size_t WS_END   = OFF_OUT + (size_t)M * 1024 * 2;
constexpr int LDS_BYTES = 160 * 1024;

DI unsigned pk_bf16(float a, float b) { f32x2 f = {a, b}; bf16x2_t v = __builtin_convertvector(f, bf16x2_t); return __builtin_bit_cast(unsigned, v); }
DI float bf_lo(unsigned u) { return __uint_as_float(u << 16); }
DI float bf_hi(unsigned u) { return __uint_as_float(u & 0xffff0000u); }
template <int CTRL> DI float dppf(float v) { return __builtin_bit_cast(float, __builtin_amdgcn_update_dpp(0, __builtin_bit_cast(int, v), CTRL, 0xF, 0xF, true)); }
DI float sum8(float v) { v += dppf<0xB1>(v); v += dppf<0x4E>(v); v += dppf<0x141>(v); return v; }
DI float sum16(float v) { v = sum8(v); v += dppf<0x140>(v); return v; }
DI int ptid(int wid_s) { int l; asm volatile("v_mbcnt_lo_u32_b32 %0, -1, 0\n\tv_mbcnt_hi_u32_b32 %0, -1, %0" : "=&v"(l)); return (wid_s << 6) | l; }
DI float xorl(float v, int lane, int mask) { return __builtin_bit_cast(float, __builtin_amdgcn_ds_bpermute((lane ^ mask) << 2, __builtin_bit_cast(int, v))); }
DI float frcp(float x) { return __builtin_amdgcn_rcpf(x); }
DI float silu(float z) { return z * frcp(1.0f + __expf(-z)); }

namespace pg8 {
#define PG8_LAS __attribute__((address_space(3)))
typedef unsigned short bf16_t;
typedef short bf16x8 __attribute__((ext_vector_type(8)));
typedef float f32x4 __attribute__((ext_vector_type(4)));
typedef unsigned u32x4 __attribute__((ext_vector_type(4)));
constexpr int BM = 256, BK = 64, HALF = 128, HTB = HALF * BK * 2  , STAGE_BYTES = 8 * HTB, NXCD = 8, WGM = 8;

__host__ __device__ __forceinline__ int lds_byte(int r, int c) { const int st = (r >> 4) * 2 + (c >> 5), rr = r & 15, cc = c & 31, ob = rr * 64 + cc * 2; return st * 1024 + (ob ^ (((ob >> 9) & 1) << 5)); }
__host__ __device__ __forceinline__ void stage_rc(int b, int& R, int& C) { const int st = b / 1024, sb = b % 1024, swz = sb ^ (((sb >> 9) & 1) << 5); R = (st >> 1) * 16 + swz / 64; C = (st & 1) * 32 + (swz % 64) / 2; }
__host__ __device__ __forceinline__ int perm32(int rho) { const int n = rho >> 4, i = rho & 15; return 8 * (i >> 2) + 4 * n + (i & 3); }

struct Unit { int pm, pn; };
struct Gemm { const bf16_t* A; const bf16_t* Bt; int M, N, K, lda, ldb; };

struct StaticOrder {
    int nM, nN, nwg, G, c;
    __host__ __device__ void init(int M, int N, int G_, int c_) { nM = M / BM; nN = N / BM; nwg = nM * nN; G = G_; c = c_; }
    __host__ __device__ bool next(int i, Unit& u) const {
        const long L = (long)i * G + c; if (L >= nwg) return false;
        int wgid = (int)L; { const int q = nwg / NXCD, r = nwg % NXCD, xcd = wgid % NXCD, off = wgid / NXCD; wgid = (xcd < r ? xcd * (q + 1) : r * (q + 1) + (xcd - r) * q) + off; }
        const int nig = WGM * nN, gid = wgid / nig, fm = gid * WGM, gsz = (nM - fm) < WGM ? (nM - fm) : WGM;
        u.pm = fm + ((wgid % nig) % gsz); u.pn = (wgid % nig) / gsz; return true;
    }
    __device__ __forceinline__ void a_ready(const Unit&) const {}
    __device__ __forceinline__ void done(const Unit&) const {}
};
struct PanelOrder { int c, nN; __device__ __forceinline__ bool next(int i, Unit& u) const { if (i >= nN) return false; u.pm = c; u.pn = i; return true; }
    __device__ __forceinline__ void a_ready(const Unit&) const {} __device__ __forceinline__ void done(const Unit&) const {} };
DI u32x4 pack8(f32x4 v0, f32x4 v1) { u32x4 w; w.x = pk_bf16(v0[0], v0[1]); w.y = pk_bf16(v0[2], v0[3]); w.z = pk_bf16(v1[0], v1[1]); w.w = pk_bf16(v1[2], v1[3]); return w; }
DI float dot8(f32x4 a, f32x4 b) { return a[0] * a[0] + a[1] * a[1] + a[2] * a[2] + a[3] * a[3] + b[0] * b[0] + b[1] * b[1] + b[2] * b[2] + b[3] * b[3]; }

template <int MODE> struct EpiStoreSS {
    static constexpr bool PERM = true, AFTER_DRAIN = false;
    DI bool skip_b1(const Unit& u) const { return MODE == 0 && u.pn == 8; }
    bf16_t* O; int ldc; float* ss0; float* ss1;
    DI void operator()(const f32x4 (&acc)[2][2][4][2], const Unit& u, int wr, int wc, int fr, int fq) const {
        asm volatile("" : "+v"(fr), "+v"(fq));
        const int row0 = u.pm * BM + wr * 64 + fr, col0 = u.pn * BM + wc * 32 + 8 * fq;
        const bool want = (MODE == 1) || (u.pn <= 1);
#pragma unroll
        for (int ai = 0; ai < 2; ++ai)
#pragma unroll
            for (int m = 0; m < 4; ++m) { __builtin_amdgcn_sched_barrier(0);
                const int row = row0 + ai * HALF + m * 16; bf16_t* rowp = O + (size_t)row * ldc + col0; float ss = 0.f;
#pragma unroll
                for (int bj = 0; bj < 2; ++bj) { const f32x4 v0 = acc[ai][bj][m][0], v1 = acc[ai][bj][m][1];
                    *(u32x4*)(rowp + bj * HALF) = pack8(v0, v1);
                    if (MODE == 1 || u.pn == 0 || bj == 0) ss += dot8(v0, v1); }
                if (want) { const int ln = fq * 16 + fr; ss += xorl(ss, ln, 16); ss += xorl(ss, ln, 32);
                    if (fq == 0) atomicAdd(((MODE == 1 || u.pn == 0) ? ss0 : ss1) + row, ss); }
            }
    }
};
struct EpiQ {
    static constexpr bool PERM = true, AFTER_DRAIN = false;
    DI bool skip_b1(const Unit&) const { return false; }
    bf16_t* Q; const float* ssq; const float* cosT; const float* sinT;
    DI void operator()(const f32x4 (&acc)[2][2][4][2], const Unit& u, int wr, int wc, int fr, int fq) const {
        asm volatile("" : "+v"(fr), "+v"(fq));
        const int row0 = u.pm * BM + wr * 64 + fr, col0 = u.pn * BM + wc * 32 + 8 * fq;
        float rsv[8];
#pragma unroll
        for (int j = 0; j < 8; ++j) rsv[j] = ssq[row0 + (j >> 2) * HALF + (j & 3) * 16];
#pragma unroll
        for (int ai = 0; ai < 2; ++ai)
#pragma unroll
            for (int m = 0; m < 4; ++m) { __builtin_amdgcn_sched_barrier(0);
                const int row = row0 + ai * HALF + m * 16, b = row >> 11, t = row & 2047;
                const float rs = rsqrtf(rsv[ai * 4 + m] * (1.0f / 256.0f) + NORM_EPS) * QSCALE;
#pragma unroll
                for (int bj = 0; bj < 2; ++bj) { const int c = col0 + bj * HALF, h = c / 192, d0 = c - h * 192;
                    f32x4 v0 = acc[ai][bj][m][0] * rs, v1 = acc[ai][bj][m][1] * rs;
                    if (d0 >= 128) { const int g = (d0 - 128) >> 3;
                        const f32x4 cs = *(const f32x4*)(cosT + (size_t)row * 32 + 4 * g), sn = *(const f32x4*)(sinT + (size_t)row * 32 + 4 * g);
                        const f32x4 o1 = v0 * cs - v1 * sn, o2 = v1 * cs + v0 * sn; v0 = o1; v1 = o2; }
                    *(u32x4*)(Q + ((size_t)(b * 4 + h) * 2048 + t) * 192 + d0) = pack8(v0, v1); }
            }
    }
};
struct EpiKN {
    static constexpr bool PERM = true, AFTER_DRAIN = false;
    DI bool skip_b1(const Unit&) const { return false; }
    bf16_t* Kc; const float* sskv;
    DI void operator()(const f32x4 (&acc)[2][2][4][2], const Unit& u, int wr, int wc, int fr, int fq) const {
        asm volatile("" : "+v"(fr), "+v"(fq));
        const int row0 = u.pm * BM + wr * 64 + fr, col0 = u.pn * BM + wc * 32 + 8 * fq;
        float rsv[8];
#pragma unroll
        for (int j = 0; j < 8; ++j) rsv[j] = sskv[row0 + (j >> 2) * HALF + (j & 3) * 16];
#pragma unroll
        for (int ai = 0; ai < 2; ++ai)
#pragma unroll
            for (int m = 0; m < 4; ++m) { __builtin_amdgcn_sched_barrier(0);
                const int row = row0 + ai * HALF + m * 16, b = row >> 11, t = row & 2047;
                const float rs = rsqrtf(rsv[ai * 4 + m] * (1.0f / 128.0f) + NORM_EPS);
#pragma unroll
                for (int bj = 0; bj < 2; ++bj) { const int c = col0 + bj * HALF, h = c >> 7, d0 = c & 127;
                    *(u32x4*)(Kc + ((size_t)(b * 4 + h) * 2048 + t) * 192 + d0) = pack8(acc[ai][bj][m][0] * rs, acc[ai][bj][m][1] * rs); }
            }
    }
};
struct EpiVT {
    static constexpr bool PERM = true, AFTER_DRAIN = false;
    DI bool skip_b1(const Unit&) const { return false; }
    bf16_t* VT; const float* sskv;
    DI void operator()(const f32x4 (&acc)[2][2][4][2], const Unit& u, int wr, int wc, int fr, int fq) const {
        asm volatile("" : "+v"(fr), "+v"(fq));
        const int row0 = u.pm * BM + wr * 64 + fr, col0 = u.pn * BM + wc * 32 + 8 * fq;
        f32x4 s0[2], s1[2];
#pragma unroll
        for (int bj = 0; bj < 2; ++bj) { const f32x4 a = *(const f32x4*)(sskv + col0 + bj * HALF), c = *(const f32x4*)(sskv + col0 + bj * HALF + 4);
#pragma unroll
            for (int j = 0; j < 4; ++j) { s0[bj][j] = rsqrtf(a[j] * (1.0f / 128.0f) + NORM_EPS); s1[bj][j] = rsqrtf(c[j] * (1.0f / 128.0f) + NORM_EPS); } }
#pragma unroll
        for (int ai = 0; ai < 2; ++ai)
#pragma unroll
            for (int m = 0; m < 4; ++m) { __builtin_amdgcn_sched_barrier(0);
                const int row = row0 + ai * HALF + m * 16, h = row >> 7, dv = row & 127;
#pragma unroll
                for (int bj = 0; bj < 2; ++bj) { const int tok = col0 + bj * HALF, b = tok >> 11, t = tok & 2047;
                    *(u32x4*)(VT + ((size_t)(b * 4 + h) * 128 + dv) * 2048 + t) = pack8(acc[ai][bj][m][0] * s0[bj], acc[ai][bj][m][1] * s1[bj]); }
            }
    }
};

template <class Epi, class Sched, bool STAMP = false>
__device__ __forceinline__ void gemm_phase(PG8_LAS unsigned char* lds, const Gemm g, const Sched& S, const Epi& E, unsigned long long* stamps, int wid_s) {
    const int tid = ptid(wid_s), wid = wid_s, lane = tid & 63, wr = wid >> 2, wc = wid & 3, fr = lane & 15, fq = lane >> 4;
    const int K = g.K, nt = K / BK;
    int ts_lo = 0, ts_hi = 0, nts = 0; const unsigned long long rt_entry = STAMP ? (unsigned long long)wall_clock64() : 0ull;
#define PG8_STAMP() do { if (STAMP && wid == 0 && nts < 64) { const unsigned long long _c = (unsigned long long)clock64(); \
        ts_lo = (lane == nts) ? (int)(unsigned)_c : ts_lo; ts_hi = (lane == nts) ? (int)(unsigned)(_c >> 32) : ts_hi; ++nts; } } while (0)
    PG8_STAMP();
    unsigned voffA[2], voffB[2];
#pragma unroll
    for (int i = 0; i < 2; ++i) { int R, C; stage_rc(tid * 16 + i * 8192, R, C); const int Rb = Epi::PERM ? ((R & ~31) + perm32(R & 31)) : R;
        voffA[i] = (unsigned)(R * g.lda + C) * 2u; voffB[i] = (unsigned)(Rb * g.ldb + C) * 2u; }
    const size_t kstep = (size_t)(BK * 2);
    const size_t hsA = (size_t)HALF * g.lda * 2, hsB = (size_t)HALF * g.ldb * 2;
    const size_t tsA = 2 * hsA, tsB = 2 * hsB;
    const unsigned ldsw = (unsigned)wid * 1024u;
    const int aoff = lds_byte(wr * 64 + fr, fq * 8), boff = lds_byte(wc * 32 + fr, fq * 8);
#define PG8_SA(b, h) (((b) * 2 + (h)) * HTB)
#define PG8_SB(b, h) ((4 + (b) * 2 + (h)) * HTB)
#define PG8_STAGE(bufoff, gbase, voff) do { _Pragma("unroll") for (int _i = 0; _i < 2; ++_i) \
        __builtin_amdgcn_global_load_lds((const unsigned*)((const char*)(gbase) + (voff)[_i]), (PG8_LAS unsigned*)(lds + (bufoff) + ldsw + _i * 8192), 16, 0, 0); } while (0)
#define PG8_LDA(dst, b, h) do { _Pragma("unroll") for (int m = 0; m < 4; ++m) _Pragma("unroll") for (int k = 0; k < 2; ++k) dst[m][k] = *(const PG8_LAS bf16x8*)(lds + PG8_SA(b, h) + aoff + m * 2048 + k * 1024); } while (0)
#define PG8_LDB(dst, b, h) do { _Pragma("unroll") for (int n = 0; n < 2; ++n) _Pragma("unroll") for (int k = 0; k < 2; ++k) dst[n][k] = *(const PG8_LAS bf16x8*)(lds + PG8_SB(b, h) + boff + n * 2048 + k * 1024); } while (0)
#define PG8_MMA(ai, bj, At, Bt) do { __builtin_amdgcn_s_setprio(1); _Pragma("unroll") for (int m = 0; m < 4; ++m) _Pragma("unroll") for (int n = 0; n < 2; ++n) _Pragma("unroll") for (int k = 0; k < 2; ++k) \
        acc[ai][bj][m][n] = __builtin_amdgcn_mfma_f32_16x16x32_bf16(Bt[n][k], At[m][k], acc[ai][bj][m][n], 0, 0, 0); __builtin_amdgcn_s_setprio(0); } while (0)
#define PG8_WAIT_V(n) asm volatile("s_waitcnt vmcnt(" #n ")" ::: "memory")
#define PG8_WAIT_L(n) asm volatile("s_waitcnt lgkmcnt(" #n ")" ::: "memory")
#define PG8_BAR __builtin_amdgcn_s_barrier()
#define PG8_SCHED __builtin_amdgcn_sched_barrier(0)
    Unit cur, nxt; int ui = 0;
    if (!S.next(0, cur)) return;
    f32x4 acc[2][2][4][2];
#pragma unroll
    for (int a = 0; a < 2; ++a)
#pragma unroll
        for (int b = 0; b < 2; ++b)
#pragma unroll
            for (int m = 0; m < 4; ++m)
#pragma unroll
                for (int n = 0; n < 2; ++n) acc[a][b][m][n] = (f32x4){0.f, 0.f, 0.f, 0.f};
    bf16x8 At[4][2], B0[2][2], B1[2][2];
    const char* cA = (const char*)g.A + (size_t)cur.pm * tsA; const char* cB = (const char*)g.Bt + (size_t)cur.pn * tsB;
    S.a_ready(cur);
    PG8_STAGE(PG8_SB(0, 0), cB, voffB); PG8_STAGE(PG8_SA(0, 0), cA, voffA); PG8_STAGE(PG8_SB(0, 1), cB + hsB, voffB); PG8_STAGE(PG8_SA(0, 1), cA + hsA, voffA);
    if (wr == 1) PG8_BAR;
    PG8_WAIT_V(4); PG8_BAR;
    PG8_STAGE(PG8_SB(1, 0), cB + kstep, voffB); PG8_STAGE(PG8_SA(1, 0), cA + kstep, voffA); PG8_STAGE(PG8_SB(1, 1), cB + hsB + kstep, voffB);
    PG8_WAIT_V(6); PG8_BAR;
    PG8_STAMP();
    for (;;) {
        const bool has_next = S.next(ui + 1, nxt);
        const bool skb1 = E.skip_b1(cur);
        const char* nA = has_next ? (const char*)g.A + (size_t)nxt.pm * tsA : cA; const char* nB = has_next ? (const char*)g.Bt + (size_t)nxt.pn * tsB : cB;
        for (int t = 0; t < nt; t += 2) {
            const bool last = (t == nt - 2);
            const char* a1 = cA + (size_t)(t + 1) * kstep;
            const char* a2 = last ? nA : cA + (size_t)(t + 2) * kstep; const char* b2 = last ? nB : cB + (size_t)(t + 2) * kstep;
            const char* a3 = a2 + kstep; const char* b3 = b2 + kstep;
            if (last && has_next) S.a_ready(nxt);
            PG8_LDB(B0, 0, 0); PG8_SCHED; PG8_LDA(At, 0, 0); PG8_STAGE(PG8_SA(1, 1), a1 + hsA, voffA);
            PG8_WAIT_L(8); PG8_BAR; PG8_WAIT_L(0); PG8_MMA(0, 0, At, B0); PG8_BAR; PG8_SCHED;
            PG8_LDB(B1, 0, 1); PG8_STAGE(PG8_SB(0, 0), b2, voffB);
            PG8_BAR; PG8_WAIT_L(0); if (!skb1) PG8_MMA(0, 1, At, B1); PG8_BAR;
            PG8_LDA(At, 0, 1); PG8_STAGE(PG8_SA(0, 0), a2, voffA);
            PG8_BAR; PG8_WAIT_L(0); PG8_MMA(1, 0, At, B0); PG8_BAR; PG8_SCHED;
            PG8_STAGE(PG8_SB(0, 1), b2 + hsB, voffB);
            PG8_WAIT_V(6); PG8_BAR; if (!skb1) PG8_MMA(1, 1, At, B1); PG8_BAR;
            PG8_LDB(B0, 1, 0); PG8_SCHED; PG8_LDA(At, 1, 0); PG8_STAGE(PG8_SA(0, 1), a2 + hsA, voffA);
            PG8_WAIT_L(8); PG8_BAR; PG8_WAIT_L(0); PG8_MMA(0, 0, At, B0); PG8_BAR; PG8_SCHED;
            PG8_LDB(B1, 1, 1); PG8_STAGE(PG8_SB(1, 0), b3, voffB);
            PG8_BAR; PG8_WAIT_L(0); if (!skb1) PG8_MMA(0, 1, At, B1); PG8_BAR;
            PG8_LDA(At, 1, 1); PG8_STAGE(PG8_SA(1, 0), a3, voffA);
            PG8_BAR; PG8_WAIT_L(0); PG8_MMA(1, 0, At, B0); PG8_BAR; PG8_SCHED;
            PG8_STAGE(PG8_SB(1, 1), b3 + hsB, voffB);
            PG8_WAIT_V(6); PG8_BAR; if (!skb1) PG8_MMA(1, 1, At, B1); PG8_BAR;
        }
        PG8_STAMP();
        if constexpr (!Epi::AFTER_DRAIN) { E(acc, cur, wr, wc, fr, fq); S.done(cur); }
        PG8_STAMP();
        if (!has_next) break;
#pragma unroll
        for (int a = 0; a < 2; ++a)
#pragma unroll
            for (int b = 0; b < 2; ++b)
#pragma unroll
                for (int m = 0; m < 4; ++m)
#pragma unroll
                    for (int n = 0; n < 2; ++n) acc[a][b][m][n] = (f32x4){0.f, 0.f, 0.f, 0.f};
        cur = nxt; cA = nA; cB = nB; ++ui;
    }
    PG8_WAIT_V(0);
    if (wr == 0) PG8_BAR;
    PG8_BAR;
    if constexpr (Epi::AFTER_DRAIN) { E.fused(acc, cur, wr, wc, fr, fq, lds, wid, lane); S.done(cur); }
    PG8_STAMP();
    if (STAMP && wid == 0) { stamps[lane] = lane < nts ? (((unsigned long long)(unsigned)ts_hi << 32) | (unsigned)ts_lo) : 0ull;
        if (lane == 62) stamps[62] = rt_entry; if (lane == 63) stamps[63] = (unsigned long long)wall_clock64(); }
#undef PG8_STAMP
#undef PG8_SA
#undef PG8_SB
#undef PG8_STAGE
#undef PG8_LDA
#undef PG8_LDB
#undef PG8_MMA
#undef PG8_WAIT_V
#undef PG8_WAIT_L
#undef PG8_BAR
#undef PG8_SCHED
}
}
using pg8::bf16_t; using pg8::bf16x8; using pg8::f32x4; using pg8::u32x4;
typedef __attribute__((address_space(3))) unsigned char lds_u8;

struct Params {
    const float* x; const int* pos; const float* g_pre; const float* w_in; const float* g_q; const float* w_uq; const float* g_kv; const float* w_ukv;
    const float* mu; const float* w0; const float* w2; const float* a0; const float* a2; const float* k_k; const float* k_a; const float* r_k;
    const float* ln_g; const float* ln_b; const float* w_out; const float* g_post; float* out; unsigned char* ws;
};

DI int map_in(int n) {
    if (n < 448) return n;
    if (n < 512) return -1;
    if (n < 2048) return n - 64;
    if (n < 2176) return n - 64;
    if (n < 2304) return -1;
    return n - 192;
}
DI int map_q(int n) {
    const int h = n / 192, d = n - h * 192;
    if (d < 128) return n;
    const int j = d - 128, g = j >> 3, i = j & 7, orig = (i < 4) ? (4 * g + i) : (32 + 4 * g + (i - 4));
    return h * 192 + 128 + orig;
}
DI void wconv_tile(int tid, float* tl, int mode, int tn, int tk, const float* src, int ld, int Ksrc, int Kdst, const float* gain, bf16_t* dst) {
    const int n0 = tn * 64, k0 = tk * 64;
#pragma unroll
    for (int e = 0; e < 8; ++e) { const int idx = tid + 512 * e, kk = idx >> 6, nn = idx & 63, n = n0 + nn, k = k0 + kk;
        int sc;
        if (mode == 0) sc = map_in(n); else if (mode == 1) sc = map_q(n); else if (mode == 2) sc = (n >> 7) * 256 + (n & 127); else if (mode == 3) sc = (n >> 7) * 256 + 128 + (n & 127); else sc = n;
        float v = 0.f;
        if (k < Ksrc && sc >= 0) { v = src[(size_t)k * ld + sc]; if (gain) v *= gain[k]; }
        tl[kk * 65 + nn] = v; }
    __syncthreads();
#pragma unroll
    for (int e = 0; e < 8; ++e) { const int idx = tid + 512 * e, nn = idx >> 6, kk = idx & 63;
        const float v = tl[kk * 65 + nn];
        dst[(size_t)(n0 + nn) * Kdst + k0 + kk] = (bf16_t)(pk_bf16(v, 0.f) & 0xffffu); }
    __syncthreads();
}
DI void phase0(const Params& p, float* tl, int wid_s) {
    const int tid = ptid(wid_s), lane = tid & 63, bid = blockIdx.x, G = gridDim.x;
    unsigned char* ws = p.ws;
    for (int i = bid; i < 832 + 48 + 32 + 32 + 256; i += G) {
        if (i < 832) wconv_tile(tid, tl, 0, i >> 4, i & 15, p.w_in, DIN, 1024, 1024, nullptr, (bf16_t*)(ws + OFF_WIN));
        else if (i < 880) { const int j = i - 832; wconv_tile(tid, tl, 1, j >> 2, j & 3, p.w_uq, 768, 256, 256, p.g_q, (bf16_t*)(ws + OFF_WUQ)); }
        else if (i < 912) { const int j = i - 880; wconv_tile(tid, tl, 2, j >> 2, j & 3, p.w_ukv, 1024, 128, 256, p.g_kv, (bf16_t*)(ws + OFF_WKN)); }
        else if (i < 944) { const int j = i - 912; wconv_tile(tid, tl, 3, j >> 2, j & 3, p.w_ukv, 1024, 128, 256, p.g_kv, (bf16_t*)(ws + OFF_WV)); }
        else { const int j = i - 944; wconv_tile(tid, tl, 4, j >> 4, j & 15, p.w_out, 1024, 1024, 1024, nullptr, (bf16_t*)(ws + OFF_WOUT)); }
    }
    { float* ss = (float*)(ws + OFF_SS); for (int i = bid * 512 + tid; i < 3 * M; i += G * 512) ss[i] = 0.f; }
    { float* cs = (float*)(ws + OFF_ROPE); float* sn = cs + (size_t)M * 32;
      const float inv = powf(10000.0f, -(float)(2 * (tid & 31)) * (1.0f / 64.0f));
      for (int i = bid * 512 + tid; i < M * 32; i += G * 512) { const int m = i >> 5;
          const float ang = (float)p.pos[m] * inv;
          float rev = ang * 0.15915494309189535f; rev -= rintf(rev);
          cs[i] = __builtin_amdgcn_cosf(rev); sn[i] = __builtin_amdgcn_sinf(rev); } }
    { bf16_t* U = (bf16_t*)(ws + OFF_U); const int gw = bid * 8 + (tid >> 6), nw = G * 8;
      f32x4 g[4];
#pragma unroll
      for (int i = 0; i < 4; ++i) g[i] = *(const f32x4*)(p.g_pre + (lane + 64 * i) * 4);
      for (int row = gw; row < M; row += nw) { const float* xr = p.x + (size_t)row * D; f32x4 v[4]; float ss = 0.f;
#pragma unroll
          for (int i = 0; i < 4; ++i) { v[i] = __builtin_nontemporal_load((const f32x4*)(xr + (lane + 64 * i) * 4)); ss += v[i][0] * v[i][0] + v[i][1] * v[i][1] + v[i][2] * v[i][2] + v[i][3] * v[i][3]; }
          ss = sum16(ss); ss += xorl(ss, lane, 16); ss += xorl(ss, lane, 32);
          const float rs = rsqrtf(ss * (1.0f / 1024.0f) + NORM_EPS);
#pragma unroll
          for (int i = 0; i < 4; ++i) { u32x2 w; w.x = pk_bf16(v[i][0] * rs * g[i][0], v[i][1] * rs * g[i][1]); w.y = pk_bf16(v[i][2] * rs * g[i][2], v[i][3] * rs * g[i][3]);
              *(u32x2*)(U + (size_t)row * D + (lane + 64 * i) * 4) = w; } } }
}
DI void phase_krope(const Params& p, int wid_s) {
    const unsigned char* ws = p.ws; const bf16_t* P = (const bf16_t*)(ws + OFF_P); bf16_t* Kc = (bf16_t*)(p.ws + OFF_K);
    const float* cs = (const float*)(ws + OFF_ROPE); const float* sn = cs + (size_t)M * 32;
    for (int i = blockIdx.x * 512 + ptid(wid_s); i < M * 8; i += gridDim.x * 512) { const int m = i >> 3, g = i & 7, b = m >> 11, t = m & 2047;
        const u32x2 a = *(const u32x2*)(P + (size_t)m * NP + C_KR + 4 * g), c = *(const u32x2*)(P + (size_t)m * NP + C_KR + 32 + 4 * g);
        const f32x4 x1 = {bf_lo(a.x), bf_hi(a.x), bf_lo(a.y), bf_hi(a.y)}, x2 = {bf_lo(c.x), bf_hi(c.x), bf_lo(c.y), bf_hi(c.y)};
        const f32x4 co = *(const f32x4*)(cs + (size_t)m * 32 + 4 * g), si = *(const f32x4*)(sn + (size_t)m * 32 + 4 * g);
        const u32x4 w = pg8::pack8(x1 * co - x2 * si, x2 * co + x1 * si);
#pragma unroll
        for (int h = 0; h < 4; ++h) *(u32x4*)(Kc + ((size_t)(b * 4 + h) * 2048 + t) * 192 + 128 + 8 * g) = w; }
}
DI void phase_final(const Params& p, int wid_s, int row0, int nrows, int nw, int gw) {
    const int tid = ptid(wid_s), lane = tid & 63; const bf16_t* O = (const bf16_t*)(p.ws + OFF_OUT); const float* sso = (const float*)(p.ws + OFF_SS) + 2 * M;
    f32x4 g[4];
#pragma unroll
    for (int i = 0; i < 4; ++i) g[i] = *(const f32x4*)(p.g_post + (lane + 64 * i) * 4);
    for (int row = row0 + gw; row < row0 + nrows; row += nw) { const float rs = rsqrtf(sso[row] * (1.0f / 1024.0f) + NORM_EPS);
#pragma unroll
        for (int i = 0; i < 4; ++i) { const size_t o = (size_t)row * D + (lane + 64 * i) * 4; const f32x4 xv = __builtin_nontemporal_load((const f32x4*)(p.x + o)); const u32x2 ov = *(const u32x2*)(O + o);
            f32x4 r; r[0] = xv[0] + bf_lo(ov.x) * rs * g[i][0]; r[1] = xv[1] + bf_hi(ov.x) * rs * g[i][1]; r[2] = xv[2] + bf_lo(ov.y) * rs * g[i][2]; r[3] = xv[3] + bf_hi(ov.y) * rs * g[i][3];
            __builtin_nontemporal_store(r, (f32x4*)(p.out + o)); } }
}

#define MFMA32(a, b, c) __builtin_amdgcn_mfma_f32_32x32x16_bf16((a), (b), (c), 0, 0, 0)
constexpr int KROW = 400, VROW = 136, KT_BYTES = 64 * KROW, VT_BYTES = 128 * VROW;
constexpr int ATT_K0 = 0, ATT_V0 = 2 * KT_BYTES;


#define VFRAG(vb_, dt_, q_) __builtin_shufflevector(*(const __attribute__((address_space(3))) s16x4*)((vb_) + ((dt_) * 32 + r) * VROW + (((q_) >> 1) * 32 + 16 * ((q_) & 1) + 4 * hh) * 2), \
                                                    *(const __attribute__((address_space(3))) s16x4*)((vb_) + ((dt_) * 32 + r) * VROW + (((q_) >> 1) * 32 + 16 * ((q_) & 1) + 4 * hh) * 2 + 16), 0, 1, 2, 3, 4, 5, 6, 7)
#define PV_BLOCK(vb_) do { bf16x8 vf[2][4]; \
        _Pragma("unroll") for (int q_ = 0; q_ < 4; ++q_) vf[0][q_] = VFRAG(vb_, 0, q_); \
        _Pragma("unroll") for (int dt_ = 0; dt_ < 4; ++dt_) { \
            if (dt_ + 1 < 4) { _Pragma("unroll") for (int q_ = 0; q_ < 4; ++q_) vf[(dt_ + 1) & 1][q_] = VFRAG(vb_, dt_ + 1, q_); } \
            __builtin_amdgcn_sched_barrier(0); \
            _Pragma("unroll") for (int q_ = 0; q_ < 4; ++q_) o[dt_] = MFMA32(vf[dt_ & 1][q_], pf[q_ >> 1][q_ & 1], o[dt_]); \
            __builtin_amdgcn_sched_barrier(0); } } while (0)
DI void attn_item(lds_u8* lds, const Params& p, int bh, int qb, int wid_s) {
    const unsigned char* ws = p.ws;
    const bf16_t* Qg = (const bf16_t*)(ws + OFF_Q) + (size_t)bh * 2048 * 192;
    const unsigned char* Kg = ws + OFF_K + (size_t)bh * 2048 * 384;
    const unsigned char* Vg = ws + OFF_VT + (size_t)bh * 128 * 4096;
    const bf16_t* P = (const bf16_t*)(ws + OFF_P); bf16_t* Y = (bf16_t*)(p.ws + OFF_U);
    const int tid = ptid(wid_s), lane = tid & 63, w = wid_s, r = lane & 31, hh = lane >> 5;
    const int b = bh >> 2, h = bh & 3, qrow = qb * 256 + 32 * w + r;
    const int nkt = 4 * (qb + 1), my_last = qb * 4 + (w >> 1);
    int kdst[3], vsrc[2], vdst[2];
#pragma unroll
    for (int j = 0; j < 3; ++j) { const int c = tid + 512 * j, key = c / 24, part = c - key * 24; kdst[j] = key * KROW + part * 16; }
#pragma unroll
    for (int j = 0; j < 2; ++j) { const int c = tid + 512 * j, dv = c >> 3, part = c & 7; vsrc[j] = dv * 4096 + part * 16; vdst[j] = dv * VROW + part * 16; }
    bf16x8 qf[12];
#pragma unroll
    for (int s = 0; s < 12; ++s) qf[s] = *(const bf16x8*)(Qg + (size_t)qrow * 192 + 16 * s + 8 * hh);
    u32x4 kst[3], vst[2];
#pragma unroll
    for (int j = 0; j < 3; ++j) kst[j] = *(const u32x4*)(Kg + (size_t)(tid + 512 * j) * 16);
#pragma unroll
    for (int j = 0; j < 2; ++j) vst[j] = *(const u32x4*)(Vg + vsrc[j]);
#pragma unroll
    for (int j = 0; j < 3; ++j) *(u32x4*)(lds + ATT_K0 + kdst[j]) = kst[j];
#pragma unroll
    for (int j = 0; j < 2; ++j) { *(u32x2*)(lds + ATT_V0 + vdst[j]) = (u32x2){vst[j].x, vst[j].y}; *(u32x2*)(lds + ATT_V0 + vdst[j] + 8) = (u32x2){vst[j].z, vst[j].w}; }
    __syncthreads();
    f32x16 o[4];
#pragma unroll
    for (int dt = 0; dt < 4; ++dt)
#pragma unroll
        for (int i = 0; i < 16; ++i) o[dt][i] = 0.f;
    float mrow = -1e30f, lsum = 0.f; bf16x8 pf[2][2]; const bool late = w >= 4;
#pragma unroll
    for (int i = 0; i < 2; ++i)
#pragma unroll
        for (int j = 0; j < 2; ++j) pf[i][j] = (bf16x8){0, 0, 0, 0, 0, 0, 0, 0};
    for (int kt = 0; kt < nkt; ++kt) {
        const int cur = kt & 1, nxt = cur ^ 1;
        if (kt + 1 < nkt) {
#pragma unroll
            for (int j = 0; j < 3; ++j) kst[j] = *(const u32x4*)(Kg + (size_t)(kt + 1) * 64 * 384 + (size_t)(tid + 512 * j) * 16);
#pragma unroll
            for (int j = 0; j < 2; ++j) vst[j] = *(const u32x4*)(Vg + (kt + 1) * 128 + vsrc[j]);
        }
        if (late && kt >= 1 && kt - 1 <= my_last) { const lds_u8* vb = lds + ATT_V0 + nxt * VT_BYTES;
            PV_BLOCK(vb);
        }
        if (kt <= my_last) {
            const lds_u8* kb = lds + ATT_K0 + cur * KT_BYTES; const lds_u8* vb = lds + ATT_V0 + cur * VT_BYTES;
            f32x16 st[2];
#pragma unroll
            for (int sub = 0; sub < 2; ++sub)
#pragma unroll
                for (int i = 0; i < 16; ++i) st[sub][i] = 0.f;
            { bf16x8 kf[2][4];
#define KFRAG(g_, j_) (*(const __attribute__((address_space(3))) bf16x8*)(kb + (((g_) / 3) * 32 + r) * KROW + (16 * (((g_) % 3) * 4 + (j_)) + 8 * hh) * 2))
#pragma unroll
              for (int j = 0; j < 4; ++j) kf[0][j] = KFRAG(0, j);
#pragma unroll
              for (int g = 0; g < 6; ++g) {
                  if (g + 1 < 6) {
#pragma unroll
                      for (int j = 0; j < 4; ++j) kf[(g + 1) & 1][j] = KFRAG(g + 1, j); }
                  __builtin_amdgcn_sched_barrier(0);
#pragma unroll
                  for (int j = 0; j < 4; ++j) st[g / 3] = MFMA32(kf[g & 1][j], qf[(g % 3) * 4 + j], st[g / 3]);
                  __builtin_amdgcn_sched_barrier(0); }
#undef KFRAG
            }
            if (kt == my_last) {
#pragma unroll
                for (int sub = 0; sub < 2; ++sub)
#pragma unroll
                    for (int i = 0; i < 16; ++i) { const int key = kt * 64 + sub * 32 + (i & 3) + 8 * (i >> 2) + 4 * hh; if (key > qrow) st[sub][i] = -1e30f; }
            }
            float mx0 = st[0][0], mx1 = st[1][0];
#pragma unroll
            for (int i = 1; i < 16; ++i) { mx0 = fmaxf(mx0, st[0][i]); mx1 = fmaxf(mx1, st[1][i]); }
            float mx = fmaxf(mx0, mx1);
            { const unsigned mb = __builtin_bit_cast(unsigned, mx); const auto sw = __builtin_amdgcn_permlane32_swap(mb, mb, false, false);
              mx = fmaxf(__builtin_bit_cast(float, (unsigned)sw[0]), __builtin_bit_cast(float, (unsigned)sw[1])); }
            if (__builtin_amdgcn_ballot_w64(mx > mrow + 11.5f) != 0ull) {
                const float mnew = fmaxf(mrow, mx), alpha = __builtin_amdgcn_exp2f(mrow - mnew);
                mrow = mnew; lsum *= alpha;
#pragma unroll
                for (int dt = 0; dt < 4; ++dt)
#pragma unroll
                    for (int i = 0; i < 16; ++i) o[dt][i] *= alpha; }
            float ps0 = 0.f, ps1 = 0.f, ps2 = 0.f, ps3 = 0.f;
#pragma unroll
            for (int i = 0; i < 16; i += 2) { st[0][i] = __builtin_amdgcn_exp2f(st[0][i] - mrow); ps0 += st[0][i]; st[0][i + 1] = __builtin_amdgcn_exp2f(st[0][i + 1] - mrow); ps1 += st[0][i + 1];
                                              st[1][i] = __builtin_amdgcn_exp2f(st[1][i] - mrow); ps2 += st[1][i]; st[1][i + 1] = __builtin_amdgcn_exp2f(st[1][i + 1] - mrow); ps3 += st[1][i + 1]; }
            lsum += (ps0 + ps1) + (ps2 + ps3);
#pragma unroll
            for (int sub = 0; sub < 2; ++sub)
#pragma unroll
                for (int s = 0; s < 2; ++s) { u32x4 q; q.x = pk_bf16(st[sub][8 * s], st[sub][8 * s + 1]); q.y = pk_bf16(st[sub][8 * s + 2], st[sub][8 * s + 3]);
                    q.z = pk_bf16(st[sub][8 * s + 4], st[sub][8 * s + 5]); q.w = pk_bf16(st[sub][8 * s + 6], st[sub][8 * s + 7]); pf[sub][s] = __builtin_bit_cast(bf16x8, q); }
            if (!late) {
            PV_BLOCK(vb);

            }
        }
        __syncthreads();
        if (kt + 1 < nkt) {
#pragma unroll
            for (int j = 0; j < 3; ++j) *(u32x4*)(lds + ATT_K0 + nxt * KT_BYTES + kdst[j]) = kst[j];
#pragma unroll
            for (int j = 0; j < 2; ++j) { *(u32x2*)(lds + ATT_V0 + nxt * VT_BYTES + vdst[j]) = (u32x2){vst[j].x, vst[j].y}; *(u32x2*)(lds + ATT_V0 + nxt * VT_BYTES + vdst[j] + 8) = (u32x2){vst[j].z, vst[j].w}; }
        }
        __syncthreads();
    }
    if (late && nkt - 1 <= my_last) { const lds_u8* vb = lds + ATT_V0 + ((nkt - 1) & 1) * VT_BYTES;
            PV_BLOCK(vb);
    }
    __syncthreads();
    lsum += xorl(lsum, lane, 32);
    const float inv = frcp(lsum);
    const size_t m = (size_t)b * 2048 + qrow;
#pragma unroll
    for (int dt = 0; dt < 4; ++dt)
#pragma unroll
        for (int g = 0; g < 4; ++g) { const int dv0 = dt * 32 + 8 * g + 4 * hh;
            const u32x2 zz = *(const u32x2*)(P + m * NP + C_Z + h * 128 + dv0);
            const float y0 = o[dt][4 * g] * inv * silu(bf_lo(zz.x)), y1 = o[dt][4 * g + 1] * inv * silu(bf_hi(zz.x)), y2 = o[dt][4 * g + 2] * inv * silu(bf_lo(zz.y)), y3 = o[dt][4 * g + 3] * inv * silu(bf_hi(zz.y));
            u32x2 wv; wv.x = pk_bf16(y0, y1); wv.y = pk_bf16(y2, y3);
            *(u32x2*)(Y + m * 1024 + h * 128 + dv0) = wv; }
}

constexpr int CL = 16, NCH = T / CL;
constexpr int Q_RAW = 0, RAW_STRIDE = 24576;
constexpr int R_W = 0, R_NK = 4096, R_B = 8192, R_KP = 12288, R_R = 16384, R_IW = 20480;
constexpr int Q_VF = 2 * RAW_STRIDE, Q_BON = Q_VF + 16384, Q_A = Q_BON + 256, Q_XW = Q_A + 4096, Q_XA = Q_XW + 2304, Q_W2T = Q_XA + 2304, Q_A2T = Q_W2T + 9216, Q_P2 = Q_A2T + 9216;
constexpr int P2_NT = 0, P2_RT = 2304, P2_BT = 4608, P2_KT = 6912, P2_BKDT = 9216, P2_SAV = 14336, P2_DL = 19456, P2_MBT = 19712, P2_MKT = 20736, P2_PT = 22016, P2_STRIDE = 23296;
constexpr int Q_XV = Q_P2 + 2 * P2_STRIDE, Q_YS = Q_XV + 5120, Q_S0B = Q_YS + 8192, CSCAN_LDS = Q_S0B + 9216;
static_assert(CSCAN_LDS <= LDS_BYTES, "scan LDS map");
#define LDSP(TY, ptr) ((__attribute__((address_space(3))) TY*)(ptr))
#define MFMA16(a, b, c) __builtin_amdgcn_mfma_f32_16x16x32_bf16((a), (b), (c), 0, 0, 0)
DI unsigned short bf1(float v) { return (unsigned short)(pk_bf16(v, 0.f) & 0xffffu); }
DI float fast_tanh(float x) { return 1.0f - 2.0f * frcp(1.0f + __expf(2.0f * x)); }
DI f32x4 cvt4bf(const u32x2 a) { return (f32x4){bf_lo(a.x), bf_hi(a.x), bf_lo(a.y), bf_hi(a.y)}; }
DI u32x2 pack4(const f32x4 v) { u32x2 w; w.x = pk_bf16(v[0], v[1]); w.y = pk_bf16(v[2], v[3]); return w; }
DI float hsum4(const f32x4 a) { return (a[0] + a[1]) + (a[2] + a[3]); }

struct P1Raw { u32x2 cr, ck, cv, cw, ca, qr, qk, qv, qw, qa; f32x4 mu_r, mu_k, mu_v, mu_w, mu_a; };
struct P1Mid { f32x4 rs, ks, kkg, kag, rkg; };

DI void p1_load(P1Raw& R, const Params& p, int b, int h, int q, int ptid) {
    const bf16_t* P = (const bf16_t*)(p.ws + OFF_P);
    const int t = q * CL + (ptid >> 4), c4 = (ptid & 15) * 4, hc = h * 64 + c4; const bf16_t* pr = P + ((size_t)b * 2048 + t) * NP;
    R.cr = *(const u32x2*)(pr + C_R + hc); R.ck = *(const u32x2*)(pr + C_K + hc); R.cv = *(const u32x2*)(pr + C_V + hc); R.cw = *(const u32x2*)(pr + C_XW + c4); R.ca = *(const u32x2*)(pr + C_XA + c4);
    const u32x2 z = {0u, 0u}; R.qr = R.qk = R.qv = R.qw = R.qa = z;
    if (t > 0) { R.qr = *(const u32x2*)(pr - NP + C_R + hc); R.qk = *(const u32x2*)(pr - NP + C_K + hc); R.qv = *(const u32x2*)(pr - NP + C_V + hc); R.qw = *(const u32x2*)(pr - NP + C_XW + c4); R.qa = *(const u32x2*)(pr - NP + C_XA + c4); }
}
DI void p1_load_mu(P1Raw& R, const Params& p, int h, int ptid) { const int c4 = (ptid & 15) * 4, hc = h * 64 + c4;
    R.mu_r = *(const f32x4*)(p.mu + hc); R.mu_k = *(const f32x4*)(p.mu + 512 + hc); R.mu_v = *(const f32x4*)(p.mu + 1024 + hc); R.mu_w = *(const f32x4*)(p.mu + 1536 + c4); R.mu_a = *(const f32x4*)(p.mu + 1600 + c4); }
DI void p1_a(P1Mid& Mi, lds_u8* lds, const Params& p, int h, const P1Raw& R, int q, int ptid, int lane) {
    const int pw = ptid >> 6, t = ptid >> 4, c4 = (ptid & 15) * 4;
    { const int hc = h * 64 + c4; Mi.kkg = *(const f32x4*)(p.k_k + hc); Mi.kag = *(const f32x4*)(p.k_a + hc); Mi.rkg = *(const f32x4*)(p.r_k + hc); }
    lds_u8* raw = lds + Q_RAW + (q & 1) * RAW_STRIDE;
    const f32x4 cr = cvt4bf(R.cr), ck = cvt4bf(R.ck), cv = cvt4bf(R.cv), cw = cvt4bf(R.cw), ca = cvt4bf(R.ca);
    const f32x4 rs = cr + (cvt4bf(R.qr) - cr) * R.mu_r, ks = ck + (cvt4bf(R.qk) - ck) * R.mu_k, vs = cv + (cvt4bf(R.qv) - cv) * R.mu_v;
    f32x4 xw = cw + (cvt4bf(R.qw) - cw) * R.mu_w; const f32x4 xa = ca + (cvt4bf(R.qa) - ca) * R.mu_a;
    *LDSP(f32x4, raw + R_R + (t * 64 + c4) * 4) = rs;
    *LDSP(f32x4, lds + Q_VF + ((q & 3) * 1024 + t * 64 + c4) * 4) = vs;
#pragma unroll
    for (int i = 0; i < 4; ++i) xw[i] = fast_tanh(xw[i]);
    *LDSP(u32x2, lds + Q_XW + t * 144 + c4 * 2) = pack4(xw); *LDSP(u32x2, lds + Q_XA + t * 144 + c4 * 2) = pack4(xa);
    Mi.rs = rs; Mi.ks = ks;
}
DI void p1_b(lds_u8* lds, const float w0, const float a0, const P1Mid& Mi, int q, int ptid, int lane) {
    const int pw = ptid >> 6, t = ptid >> 4, c4 = (ptid & 15) * 4, fr = lane & 15, fq = lane >> 4;
    lds_u8* raw = lds + Q_RAW + (q & 1) * RAW_STRIDE;
    bf16x8 aw[2], aa[2];
#pragma unroll
    for (int s = 0; s < 2; ++s) { aw[s] = *LDSP(const bf16x8, lds + Q_XW + (4 * pw + (fr & 3)) * 144 + (32 * s + 8 * fq) * 2); aa[s] = *LDSP(const bf16x8, lds + Q_XA + (4 * pw + (fr & 3)) * 144 + (32 * s + 8 * fq) * 2); }
    f32x4 selw = {0.f, 0.f, 0.f, 0.f}, sela = {0.f, 0.f, 0.f, 0.f};
#pragma unroll
    for (int nt = 0; nt < 4; ++nt) { f32x4 cwv = {0.f, 0.f, 0.f, 0.f}, cav = {0.f, 0.f, 0.f, 0.f};
#pragma unroll
        for (int s = 0; s < 2; ++s) { const bf16x8 bw = *LDSP(const bf16x8, lds + Q_W2T + (nt * 16 + fr) * 144 + (32 * s + 8 * fq) * 2), ba = *LDSP(const bf16x8, lds + Q_A2T + (nt * 16 + fr) * 144 + (32 * s + 8 * fq) * 2);
            cwv = MFMA16(aw[s], bw, cwv); cav = MFMA16(aa[s], ba, cav); }
        const bool mine = (fq == nt);
#pragma unroll
        for (int i = 0; i < 4; ++i) { selw[i] = mine ? cwv[i] : selw[i]; sela[i] = mine ? cav[i] : sela[i]; } }
    { const int n = fq * 16 + fr;
#pragma unroll
      for (int i = 0; i < 4; ++i) { const int tt = 4 * pw + i;
          const float yv = -(selw[i] + w0), sp = fmaxf(yv, 0.f) + __logf(1.0f + __expf(-fabsf(yv)));
          const float lw = -__expf(-sp - 0.5f);
          *LDSP(float, raw + R_W + (tt * 64 + n) * 4) = __expf(lw); *LDSP(float, raw + R_IW + (tt * 64 + n) * 4) = __expf(-lw);
          *LDSP(float, lds + Q_A + (tt * 64 + n) * 4) = frcp(1.0f + __expf(-(sela[i] + a0))); } }
    { const f32x4 a = *LDSP(const f32x4, lds + Q_A + (t * 64 + c4) * 4);
      f32x4 kk = Mi.ks * Mi.kkg; const float invn = frcp(fmaxf(sqrtf(sum16(hsum4(kk * kk))), 1e-12f)); kk = kk * invn;
      const f32x4 bb = kk * a, kp = Mi.ks * (1.0f + (a - 1.0f) * Mi.kag);
      const float bon = sum16(hsum4(Mi.rs * kp * Mi.rkg));
      *LDSP(f32x4, raw + R_NK + (t * 64 + c4) * 4) = -kk; *LDSP(f32x4, raw + R_B + (t * 64 + c4) * 4) = bb; *LDSP(f32x4, raw + R_KP + (t * 64 + c4) * 4) = kp;
      if ((ptid & 15) == 0) *LDSP(float, lds + Q_BON + ((q & 3) * 16 + t) * 4) = bon; }
}
DI void p2_compute(lds_u8* lds, int q, int role, int lane) {
    const lds_u8* raw = lds + Q_RAW + (q & 1) * RAW_STRIDE; lds_u8* o = lds + Q_P2 + (q & 1) * P2_STRIDE; const int c = lane;
    if (role == 0) {
        float dprev = 1.0f; unsigned vb[8];
#pragma unroll
        for (int t = 0; t < 16; ++t) { const float d = dprev * *LDSP(const float, raw + R_W + (t * 64 + c) * 4);
            *LDSP(unsigned short, o + P2_NT + t * 144 + c * 2) = bf1(*LDSP(const float, raw + R_NK + (t * 64 + c) * 4) * dprev);
            *LDSP(unsigned short, o + P2_RT + t * 144 + c * 2) = bf1(*LDSP(const float, raw + R_R + (t * 64 + c) * 4) * d); dprev = d; }
#pragma unroll
        for (int t = 0; t < 16; t += 2) vb[t >> 1] = pk_bf16(*LDSP(const float, lds + Q_VF + ((q & 3) * 1024 + t * 64 + c) * 4), *LDSP(const float, lds + Q_VF + ((q & 3) * 1024 + (t + 1) * 64 + c) * 4));
        *LDSP(u32x4, o + P2_SAV + c * 80 + 32) = (u32x4){vb[0], vb[1], vb[2], vb[3]}; *LDSP(u32x4, o + P2_SAV + c * 80 + 48) = (u32x4){vb[4], vb[5], vb[6], vb[7]};
    } else {
        const int src = (role == 1) ? R_B : R_KP, dst = (role == 1) ? P2_BT : P2_KT; float iv = 1.0f, v[16]; unsigned wb[8];
#pragma unroll
        for (int t = 0; t < 16; ++t) { iv *= *LDSP(const float, raw + R_IW + (t * 64 + c) * 4); v[t] = *LDSP(const float, raw + src + (t * 64 + c) * 4) * iv;
            *LDSP(unsigned short, o + dst + t * 144 + c * 2) = bf1(v[t]); }
        const float dl = frcp(iv);
#pragma unroll
        for (int t = 0; t < 16; t += 2) wb[t >> 1] = pk_bf16(v[t] * dl, v[t + 1] * dl);
        const int off = (role == 1) ? 0 : 32;
        *LDSP(u32x4, o + P2_BKDT + c * 80 + off) = (u32x4){wb[0], wb[1], wb[2], wb[3]}; *LDSP(u32x4, o + P2_BKDT + c * 80 + off + 16) = (u32x4){wb[4], wb[5], wb[6], wb[7]};
        if (role == 2) *LDSP(float, o + P2_DL + c * 4) = dl;
    }
}
DI void p3_products(lds_u8* lds, int q, int pw, int lane) {
    lds_u8* o = lds + Q_P2 + (q & 1) * P2_STRIDE; const int fr = lane & 15, fq = lane >> 4;
    const int ao = (pw & 1) ? P2_KT : P2_BT, bo = (pw & 2) ? P2_RT : P2_NT;
    f32x4 acc = {0.f, 0.f, 0.f, 0.f};
#pragma unroll
    for (int s = 0; s < 2; ++s) { const bf16x8 a = *LDSP(const bf16x8, o + ao + fr * 144 + (32 * s + 8 * fq) * 2), bb = *LDSP(const bf16x8, o + bo + fr * 144 + (32 * s + 8 * fq) * 2); acc = MFMA16(a, bb, acc); }
#pragma unroll
    for (int i = 0; i < 4; ++i) { const int j = 4 * fq + i; const bool keep = (pw & 2) ? (j <= fr) : (j < fr); acc[i] = keep ? acc[i] : 0.f; }
    if (pw == 0) *LDSP(f32x4, o + P2_MBT + fr * 64 + fq * 16) = acc;
    else if (pw == 1) *LDSP(u32x2, o + P2_MKT + fr * 80 + 32 + fq * 8) = pack4(acc);
    else *LDSP(u32x2, o + P2_PT + fr * 80 + (pw == 3 ? 32 : 0) + fq * 8) = pack4(acc);
}
DI void solve_sa(lds_u8* lds, int c, int lane) {
    lds_u8* o = lds + Q_P2 + (c & 1) * P2_STRIDE; float sa[16];
#pragma unroll
    for (int g = 0; g < 4; ++g) { const f32x4 x = *LDSP(const f32x4, lds + Q_XV + lane * 80 + g * 16); sa[4 * g] = x[0]; sa[4 * g + 1] = x[1]; sa[4 * g + 2] = x[2]; sa[4 * g + 3] = x[3]; }
    f32x4 mr[2][4];
    mr[1][0] = *LDSP(const f32x4, o + P2_MBT + 64);
#pragma unroll
    for (int t = 1; t < 16; ++t) {
        if (t + 1 < 16) {
#pragma unroll
            for (int g = 0; g < (t + 4) / 4; ++g) mr[(t + 1) & 1][g] = *LDSP(const f32x4, o + P2_MBT + (t + 1) * 64 + g * 16); }
        float acc = sa[t];
#pragma unroll
        for (int g = 0; g < (t + 3) / 4; ++g) {
#pragma unroll
            for (int i = 0; i < 4; ++i) if (4 * g + i < t) acc += sa[4 * g + i] * mr[t & 1][g][i]; }
        sa[t] = acc;
        __builtin_amdgcn_sched_barrier(0);
    }
    *LDSP(u32x4, o + P2_SAV + lane * 80) = (u32x4){pk_bf16(sa[0], sa[1]), pk_bf16(sa[2], sa[3]), pk_bf16(sa[4], sa[5]), pk_bf16(sa[6], sa[7])};
    *LDSP(u32x4, o + P2_SAV + lane * 80 + 16) = (u32x4){pk_bf16(sa[8], sa[9]), pk_bf16(sa[10], sa[11]), pk_bf16(sa[12], sa[13]), pk_bf16(sa[14], sa[15])};
}
DI void post_chunk(lds_u8* lds, const Params& p, const f32x4 lng, const f32x4 lnb, const u32x2 zraw, int b, int h, int c, int td) {
    bf16_t* Y = (bf16_t*)(p.ws + OFF_U);
    const int t = td >> 4, c4 = (td & 15) * 4, hc = h * 64 + c4; const size_t m = (size_t)b * 2048 + c * CL + t;
    const f32x4 y = *LDSP(const f32x4, lds + Q_YS + ((c & 1) * 1024 + t * 64 + c4) * 4), vs = *LDSP(const f32x4, lds + Q_VF + ((c & 3) * 1024 + t * 64 + c4) * 4); const float bon = *LDSP(const float, lds + Q_BON + ((c & 3) * 16 + t) * 4);
    const float mean = sum16(hsum4(y)) * (1.0f / 64.0f); const f32x4 d = y - mean; const float rstd = rsqrtf(sum16(hsum4(d * d)) * (1.0f / 64.0f) + GN_EPS);
    const f32x4 z = cvt4bf(zraw); f32x4 o = d * rstd * lng + lnb + bon * vs;
#pragma unroll
    for (int i = 0; i < 4; ++i) o[i] *= silu(z[i]);
    *(u32x2*)(Y + m * 1024 + 512 + hc) = pack4(o);
}

DI void scan_unit(lds_u8* lds, const Params& p, int bh, int wid_s) {
    const int tid = ptid(wid_s), lane = tid & 63, wv = wid_s;
    const int b = bh >> 3, h = bh & 7;
    const bf16_t* P = (const bf16_t*)(p.ws + OFF_P);
#pragma unroll 1
    for (int j0 = 0; j0 < 4; j0 += 4) { f32x4 wv[4];
#pragma unroll
        for (int j = 0; j < 4; ++j) { const int ch = tid + 512 * (j0 + j), mat = ch >> 10, k = (ch >> 4) & 63, n4 = (ch & 15) * 4; wv[j] = *(const f32x4*)((mat ? p.a2 : p.w2) + (size_t)k * 512 + h * 64 + n4); }
#pragma unroll
        for (int j = 0; j < 4; ++j) { const int ch = tid + 512 * (j0 + j), mat = ch >> 10, k = (ch >> 4) & 63, n4 = (ch & 15) * 4;
#pragma unroll
            for (int i = 0; i < 4; ++i) *LDSP(unsigned short, lds + (mat ? Q_A2T : Q_W2T) + (n4 + i) * 144 + k * 2) = bf1(wv[j][i]); } }
    for (int i = tid; i < 9216 / 4; i += 512) *LDSP(unsigned, lds + Q_S0B + i * 4) = 0u;
    for (int i = tid; i < 2 * (5120 / 4); i += 512) { const int par = i / 1280, j = i - par * 1280; *LDSP(unsigned, lds + Q_P2 + par * P2_STRIDE + P2_SAV + j * 4) = 0u; }
    for (int i = tid; i < 2 * (1280 / 4); i += 512) { const int par = i / 320, j = i - par * 320; *LDSP(unsigned, lds + Q_P2 + par * P2_STRIDE + P2_MKT + j * 4) = 0u; }
    __syncthreads();
    const int pw = wv - 4;
    P1Raw R; P1Mid Mi; u32x2 zpre = {0u, 0u}; f32x4 lng = {0.f, 0.f, 0.f, 0.f}, lnb = lng; const float w0l = p.w0[h * 64 + lane], a0l = p.a0[h * 64 + lane];
    if (wv >= 4) { const int ptd0 = tid - 256, c4 = (ptd0 & 15) * 4, hc = h * 64 + c4;
        p1_load(R, p, b, h, 0, ptd0); p1_load_mu(R, p, h, ptd0);
    }
    f32x4 sacc[2] = {{0.f, 0.f, 0.f, 0.f}, {0.f, 0.f, 0.f, 0.f}}, yacc = {0.f, 0.f, 0.f, 0.f};
    for (int c = -2; c < NCH; ++c) {
        int lane_l = lane; asm volatile("" : "+v"(lane_l));
        const int fr = lane_l & 15, fq = lane_l >> 4, ptd = (wv - 4) * 64 + lane_l, td = wv * 64 + lane_l;
        const lds_u8* o = lds + Q_P2 + (c & 1) * P2_STRIDE;
        if (wv < 4 && c >= 1) { zpre = *(const u32x2*)(P + ((size_t)b * 2048 + (c - 1) * CL + (td >> 4)) * NP + C_Z + 512 + h * 64 + (td & 15) * 4);
            lng = *(const f32x4*)(p.ln_g + h * 64 + (td & 15) * 4); lnb = *(const f32x4*)(p.ln_b + h * 64 + (td & 15) * 4); }
        if (c >= 0) {
            if (wv < 4) { const int rt = wv; f32x4 acc = {0.f, 0.f, 0.f, 0.f};
#pragma unroll
                for (int s = 0; s < 2; ++s) { const bf16x8 a = *LDSP(const bf16x8, lds + Q_S0B + (rt * 16 + fr) * 144 + (32 * s + 8 * fq) * 2), bb = *LDSP(const bf16x8, o + P2_NT + fr * 144 + (32 * s + 8 * fq) * 2); acc = MFMA16(a, bb, acc); }
                { const bf16x8 a = *LDSP(const bf16x8, o + P2_SAV + (rt * 16 + fr) * 80 + fq * 16), bb = *LDSP(const bf16x8, o + P2_MKT + fr * 80 + fq * 16); acc = MFMA16(a, bb, acc); }
#pragma unroll
                for (int i = 0; i < 4; ++i) *LDSP(float, lds + Q_XV + (rt * 16 + 4 * fq + i) * 80 + fr * 4) = acc[i];
                yacc = (f32x4){0.f, 0.f, 0.f, 0.f};
#pragma unroll
                for (int s = 0; s < 2; ++s) { const bf16x8 a = *LDSP(const bf16x8, lds + Q_S0B + (rt * 16 + fr) * 144 + (32 * s + 8 * fq) * 2), bb = *LDSP(const bf16x8, o + P2_RT + fr * 144 + (32 * s + 8 * fq) * 2); yacc = MFMA16(a, bb, yacc); }
            }
        }
        if (wv >= 4) { if (c + 2 < NCH) p1_a(Mi, lds, p, h, R, c + 2, ptd, lane_l);
            if (c + 3 < NCH) p1_load(R, p, b, h, c + 3, ptd); }
        __syncthreads();
        if (wv == 0) { if (c >= 0) solve_sa(lds, c, lane_l); }
        else if (wv < 4) { if (c + 1 >= 0 && c + 1 < NCH) p2_compute(lds, c + 1, wv - 1, lane_l); }
        else { if (c + 2 < NCH) p1_b(lds, w0l, a0l, Mi, c + 2, ptd, lane_l); }
        __syncthreads();
        if (wv >= 4 && c + 3 < NCH) p1_load_mu(R, p, h, ptd);
        if (c >= 0) {
            if (wv < 4) { const int rt = wv; const bf16x8 a = *LDSP(const bf16x8, o + P2_SAV + (rt * 16 + fr) * 80 + fq * 16), bb = *LDSP(const bf16x8, o + P2_PT + fr * 80 + fq * 16);
                yacc = MFMA16(a, bb, yacc);
                *LDSP(f32x4, lds + Q_YS + ((c & 1) * 1024 + fr * 64 + rt * 16 + 4 * fq) * 4) = yacc; }
            { const int rt = wv >> 1; const bf16x8 a = *LDSP(const bf16x8, o + P2_SAV + (rt * 16 + fr) * 80 + fq * 16);
#pragma unroll
              for (int u = 0; u < 2; ++u) { const int ct = 2 * (wv & 1) + u; const float dl = *LDSP(const float, o + P2_DL + (ct * 16 + fr) * 4);
                  const bf16x8 bb = *LDSP(const bf16x8, o + P2_BKDT + (ct * 16 + fr) * 80 + fq * 16);
                  sacc[u] = MFMA16(a, bb, sacc[u] * dl);
#pragma unroll
                  for (int i = 0; i < 4; ++i) *LDSP(unsigned short, lds + Q_S0B + (rt * 16 + 4 * fq + i) * 144 + (ct * 16 + fr) * 2) = bf1(sacc[u][i]); } }
        }
        if (wv >= 4) { if (c + 1 >= 0 && c + 1 < NCH) p3_products(lds, c + 1, pw, lane_l); }
        else if (c >= 1) post_chunk(lds, p, lng, lnb, zpre, b, h, c - 1, td);
        __syncthreads();
    }
    if (wv < 4) { zpre = *(const u32x2*)(P + ((size_t)b * 2048 + (NCH - 1) * CL + (tid >> 4)) * NP + C_Z + 512 + h * 64 + (tid & 15) * 4);
        lng = *(const f32x4*)(p.ln_g + h * 64 + (tid & 15) * 4); lnb = *(const f32x4*)(p.ln_b + h * 64 + (tid & 15) * 4);
        post_chunk(lds, p, lng, lnb, zpre, b, h, NCH - 1, tid); }
}

__global__ void __launch_bounds__(512) hymba_fwd(Params p) {
    extern __shared__ __attribute__((aligned(16))) unsigned char lds_raw[];
    lds_u8* lds = (lds_u8*)lds_raw;
    cg::grid_group grid = cg::this_grid();
    unsigned char* ws = p.ws; const int G = gridDim.x, bid = blockIdx.x, wid_s = __builtin_amdgcn_readfirstlane(threadIdx.x >> 6);
    float* ss = (float*)(ws + OFF_SS);
    const float* cosT = (const float*)(ws + OFF_ROPE); const float* sinT = cosT + (size_t)M * 32;

    phase0(p, (float*)lds_raw, wid_s);
    grid.sync();
    { pg8::Gemm g{(const bf16_t*)(ws + OFF_U), (const bf16_t*)(ws + OFF_WIN), M, NP, 1024, 1024, 1024}; pg8::StaticOrder S; S.init(M, NP, G, bid);
      pg8::EpiStoreSS<0> E{(bf16_t*)(ws + OFF_P), NP, ss, ss + M};
      pg8::gemm_phase<pg8::EpiStoreSS<0>, pg8::StaticOrder>(lds, g, S, E, nullptr, wid_s); }
    grid.sync();
    { pg8::Gemm g{(const bf16_t*)(ws + OFF_P), (const bf16_t*)(ws + OFF_WUQ), M, 768, 256, NP, 256}; pg8::StaticOrder S; S.init(M, 768, G, bid);
      pg8::EpiQ E{(bf16_t*)(ws + OFF_Q), ss, cosT, sinT};
      pg8::gemm_phase<pg8::EpiQ, pg8::StaticOrder>(lds, g, S, E, nullptr, wid_s); }
    { pg8::Gemm g{(const bf16_t*)(ws + OFF_P) + C_CKV, (const bf16_t*)(ws + OFF_WKN), M, 512, 128, NP, 256}; pg8::StaticOrder S; S.init(M, 512, G, bid);
      pg8::EpiKN E{(bf16_t*)(ws + OFF_K), ss + M};
      pg8::gemm_phase<pg8::EpiKN, pg8::StaticOrder>(lds, g, S, E, nullptr, wid_s); }
    { pg8::Gemm g{(const bf16_t*)(ws + OFF_WV), (const bf16_t*)(ws + OFF_P) + C_CKV, 512, M, 128, 256, NP}; pg8::StaticOrder S; S.init(512, M, G, bid);
      pg8::EpiVT E{(bf16_t*)(ws + OFF_VT), ss + M};
      pg8::gemm_phase<pg8::EpiVT, pg8::StaticOrder>(lds, g, S, E, nullptr, wid_s); }
    phase_krope(p, wid_s);
    grid.sync();
    for (int u = bid; u < 256; u += G) scan_unit(lds, p, u, wid_s);
    __syncthreads();
    for (int pr = bid; pr < 512; pr += G) { const int bh = pr >> 2, j = pr & 3;
        attn_item(lds, p, bh, 7 - j, wid_s);
        attn_item(lds, p, bh, j, wid_s); }
    grid.sync();
    if (G == M / 256) {
        { pg8::Gemm g{(const bf16_t*)(ws + OFF_U), (const bf16_t*)(ws + OFF_WOUT), M, 1024, 1024, 1024, 1024}; pg8::PanelOrder S{bid, 4};
          pg8::EpiStoreSS<1> E{(bf16_t*)(ws + OFF_OUT), 1024, ss + 2 * M, nullptr};
          pg8::gemm_phase<pg8::EpiStoreSS<1>, pg8::PanelOrder>(lds, g, S, E, nullptr, wid_s); }
        __threadfence(); __syncthreads();
        phase_final(p, wid_s, bid * 256, 256, 8, wid_s);
    } else {
        { pg8::Gemm g{(const bf16_t*)(ws + OFF_U), (const bf16_t*)(ws + OFF_WOUT), M, 1024, 1024, 1024, 1024}; pg8::StaticOrder S; S.init(M, 1024, G, bid);
          pg8::EpiStoreSS<1> E{(bf16_t*)(ws + OFF_OUT), 1024, ss + 2 * M, nullptr};
          pg8::gemm_phase<pg8::EpiStoreSS<1>, pg8::StaticOrder>(lds, g, S, E, nullptr, wid_s); }
        grid.sync();
        phase_final(p, wid_s, 0, M, G * 8, bid * 8 + wid_s);
    }
}

extern "C" void kernel_launch(void* const* d_in, const int* in_sizes, int n_in, void* d_out, int out_size, void* d_ws, size_t ws_size, hipStream_t stream) {
    static int grid = 0;
    if (grid == 0) {
        if (n_in != 20 || out_size != M * D || ws_size < WS_END) { fprintf(stderr, "kernel_launch: unexpected shapes (n_in %d, out %d, ws %zu < %zu)\n", n_in, out_size, ws_size, (size_t)WS_END); grid = -1; return; }
        int dev = 0, cus = 0, per_cu = 0;
        hipGetDevice(&dev); hipDeviceGetAttribute(&cus, hipDeviceAttributeMultiprocessorCount, dev);
        if (hipFuncSetAttribute((const void*)hymba_fwd, hipFuncAttributeMaxDynamicSharedMemorySize, LDS_BYTES) != hipSuccess) { fprintf(stderr, "kernel_launch: hipFuncSetAttribute failed\n"); grid = -1; return; }
        if (hipOccupancyMaxActiveBlocksPerMultiprocessor(&per_cu, (const void*)hymba_fwd, 512, LDS_BYTES) != hipSuccess || per_cu < 1) { fprintf(stderr, "kernel_launch: occupancy query gave %d\n", per_cu); per_cu = 1; (void)hipGetLastError(); }
        grid = cus;
    }
    if (grid < 0) return;
    Params p{};
    p.x = (const float*)d_in[0]; p.pos = (const int*)d_in[1]; p.g_pre = (const float*)d_in[2]; p.w_in = (const float*)d_in[3]; p.g_q = (const float*)d_in[4]; p.w_uq = (const float*)d_in[5];
    p.g_kv = (const float*)d_in[6]; p.w_ukv = (const float*)d_in[7]; p.mu = (const float*)d_in[8]; p.w0 = (const float*)d_in[9]; p.w2 = (const float*)d_in[10]; p.a0 = (const float*)d_in[11];
    p.a2 = (const float*)d_in[12]; p.k_k = (const float*)d_in[13]; p.k_a = (const float*)d_in[14]; p.r_k = (const float*)d_in[15]; p.ln_g = (const float*)d_in[16]; p.ln_b = (const float*)d_in[17];
    p.w_out = (const float*)d_in[18]; p.g_post = (const float*)d_in[19]; p.out = (float*)d_out; p.ws = (unsigned char*)d_ws;
    void* args[] = {&p};
    hipError_t e = hipLaunchCooperativeKernel((const void*)hymba_fwd, dim3(grid), dim3(512), args, LDS_BYTES, stream);
    if (e != hipSuccess) fprintf(stderr, "kernel_launch: cooperative launch failed: %s (grid %d)\n", hipGetErrorString(e), grid);
}
```

```cpp
#include <hip/hip_runtime.h>
#include <hip/hip_cooperative_groups.h>
#include <cstdio>
namespace cg = cooperative_groups;

#define DI __device__ __forceinline__
typedef float f32x16 __attribute__((ext_vector_type(16)));
typedef float f32x2 __attribute__((ext_vector_type(2)));
typedef short s16x4 __attribute__((ext_vector_type(4)));
typedef unsigned u32x2 __attribute__((ext_vector_type(2)));
typedef __bf16 bf16x2_t __attribute__((ext_vector_type(2)));

constexpr int NB = 32, T = 2048, M = NB * T, D = 1024, DIN = 3136, NP = 3328;
constexpr int C_CKV = 256, C_KR = 384, C_R = 512, C_K = 1024, C_V = 1536, C_XW = 2048, C_XA = 2112, C_Z = 2304;
constexpr float NORM_EPS = 1e-6f, GN_EPS = 64e-5f;
constexpr float QSCALE = 0.07216878364870322f * 1.4426950408889634f;

constexpr size_t OFF_WIN  = 0;
constexpr size_t OFF_WUQ  = OFF_WIN + (size_t)NP * 1024 * 2;
constexpr size_t OFF_WKN  = OFF_WUQ + (size_t)768 * 256 * 2;
constexpr size_t OFF_WV   = OFF_WKN + (size_t)512 * 256 * 2;
constexpr size_t OFF_WOUT = OFF_WV + (size_t)512 * 256 * 2;
constexpr size_t OFF_SS   = OFF_WOUT + (size_t)1024 * 1024 * 2;
constexpr size_t OFF_ROPE = OFF_SS + (size_t)3 * M * 4;
constexpr size_t OFF_U    = OFF_ROPE + (size_t)2 * M * 32 * 4;
constexpr size_t OFF_P    = OFF_U + (size_t)M * 1024 * 2;
constexpr size_t OFF_Q    = OFF_P + (size_t)M * NP * 2;
constexpr size_t OFF_K    = OFF_Q + (size_t)128 * 2048 * 192 * 2;
constexpr size_t OFF_VT   = OFF_K + (size_t)128 * 2048 * 192 * 2;
constexpr size_t OFF_OUT  = OFF_VT + (size_t)128 * 128 * 2048 * 2;
constexpr size_t WS_END   = OFF_OUT + (size_t)M * 1024 * 2;
constexpr int LDS_BYTES = 160 * 1024;

DI unsigned pk_bf16(float a, float b) { f32x2 f = {a, b}; bf16x2_t v = __builtin_convertvector(f, bf16x2_t); return __builtin_bit_cast(unsigned, v); }
DI float bf_lo(unsigned u) { return __uint_as_float(u << 16); }
DI float bf_hi(unsigned u) { return __uint_as_float(u & 0xffff0000u); }
template <int CTRL> DI float dppf(float v) { return __builtin_bit_cast(float, __builtin_amdgcn_update_dpp(0, __builtin_bit_cast(int, v), CTRL, 0xF, 0xF, true)); }
DI float sum8(float v) { v += dppf<0xB1>(v); v += dppf<0x4E>(v); v += dppf<0x141>(v); return v; }
DI float sum16(float v) { v = sum8(v); v += dppf<0x140>(v); return v; }
DI int ptid(int wid_s) { int l; asm volatile("v_mbcnt_lo_u32_b32 %0, -1, 0\n\tv_mbcnt_hi_u32_b32 %0, -1, %0" : "=&v"(l)); return (wid_s << 6) | l; }
DI float xorl(float v, int lane, int mask) { return __builtin_bit_cast(float, __builtin_amdgcn_ds_bpermute((lane ^ mask) << 2, __builtin_bit_cast(int, v))); }
DI float frcp(float x) { return __builtin_amdgcn_rcpf(x); }
DI float silu(float z) { return z * frcp(1.0f + __expf(-z)); }

namespace pg8 {
#define PG8_LAS __attribute__((address_space(3)))
typedef unsigned short bf16_t;
typedef short bf16x8 __attribute__((ext_vector_type(8)));
typedef float f32x4 __attribute__((ext_vector_type(4)));
typedef unsigned u32x4 __attribute__((ext_vector_type(4)));
constexpr int BM = 256, BK = 64, HALF = 128, HTB = HALF * BK * 2  , STAGE_BYTES = 8 * HTB, NXCD = 8, WGM = 8;

__host__ __device__ __forceinline__ int lds_byte(int r, int c) { const int st = (r >> 4) * 2 + (c >> 5), rr = r & 15, cc = c & 31, ob = rr * 64 + cc * 2; return st * 1024 + (ob ^ (((ob >> 9) & 1) << 5)); }
__host__ __device__ __forceinline__ void stage_rc(int b, int& R, int& C) { const int st = b / 1024, sb = b % 1024, swz = sb ^ (((sb >> 9) & 1) << 5); R = (st >> 1) * 16 + swz / 64; C = (st & 1) * 32 + (swz % 64) / 2; }
__host__ __device__ __forceinline__ int perm32(int rho) { const int n = rho >> 4, i = rho & 15; return 8 * (i >> 2) + 4 * n + (i & 3); }

struct Unit { int pm, pn; };
struct Gemm { const bf16_t* A; const bf16_t* Bt; int M, N, K, lda, ldb; };

struct StaticOrder {
    int nM, nN, nwg, G, c;
    __host__ __device__ void init(int M, int N, int G_, int c_) { nM = M / BM; nN = N / BM; nwg = nM * nN; G = G_; c = c_; }
    __host__ __device__ bool next(int i, Unit& u) const {
        const long L = (long)i * G + c; if (L >= nwg) return false;
        int wgid = (int)L; { const int q = nwg / NXCD, r = nwg % NXCD, xcd = wgid % NXCD, off = wgid / NXCD; wgid = (xcd < r ? xcd * (q + 1) : r * (q + 1) + (xcd - r) * q) + off; }
        const int nig = WGM * nN, gid = wgid / nig, fm = gid * WGM, gsz = (nM - fm) < WGM ? (nM - fm) : WGM;
        u.pm = fm + ((wgid % nig) % gsz); u.pn = (wgid % nig) / gsz; return true;
    }
    __device__ __forceinline__ void a_ready(const Unit&) const {}
    __device__ __forceinline__ void done(const Unit&) const {}
};
struct PanelOrder { int c, nN; __device__ __forceinline__ bool next(int i, Unit& u) const { if (i >= nN) return false; u.pm = c; u.pn = i; return true; }
    __device__ __forceinline__ void a_ready(const Unit&) const {} __device__ __forceinline__ void done(const Unit&) const {} };
DI u32x4 pack8(f32x4 v0, f32x4 v1) { u32x4 w; w.x = pk_bf16(v0[0], v0[1]); w.y = pk_bf16(v0[2], v0[3]); w.z = pk_bf16(v1[0], v1[1]); w.w = pk_bf16(v1[2], v1[3]); return w; }
DI float dot8(f32x4 a, f32x4 b) { return a[0] * a[0] + a[1] * a[1] + a[2] * a[2] + a[3] * a[3] + b[0] * b[0] + b[1] * b[1] + b[2] * b[2] + b[3] * b[3]; }

template <int MODE> struct EpiStoreSS {
    static constexpr bool PERM = true, AFTER_DRAIN = false;
    bf16_t* O; int ldc; float* ss0; float* ss1;
    DI void operator()(const f32x4 (&acc)[2][2][4][2], const Unit& u, int wr, int wc, int fr, int fq) const {
        asm volatile("" : "+v"(fr), "+v"(fq));
        const int row0 = u.pm * BM + wr * 64 + fr, col0 = u.pn * BM + wc * 32 + 8 * fq;
        const bool want = (MODE == 1) || (u.pn <= 1);
#pragma unroll
        for (int ai = 0; ai < 2; ++ai)
#pragma unroll
            for (int m = 0; m < 4; ++m) { __builtin_amdgcn_sched_barrier(0);
                const int row = row0 + ai * HALF + m * 16; bf16_t* rowp = O + (size_t)row * ldc + col0; float ss = 0.f;
#pragma unroll
                for (int bj = 0; bj < 2; ++bj) { const f32x4 v0 = acc[ai][bj][m][0], v1 = acc[ai][bj][m][1];
                    *(u32x4*)(rowp + bj * HALF) = pack8(v0, v1);
                    if (MODE == 1 || u.pn == 0 || bj == 0) ss += dot8(v0, v1); }
                if (want) { const int ln = fq * 16 + fr; ss += xorl(ss, ln, 16); ss += xorl(ss, ln, 32);
                    if (fq == 0) atomicAdd(((MODE == 1 || u.pn == 0) ? ss0 : ss1) + row, ss); }
            }
    }
};
struct EpiQ {
    static constexpr bool PERM = true, AFTER_DRAIN = false;
    bf16_t* Q; const float* ssq; const float* cosT; const float* sinT;
    DI void operator()(const f32x4 (&acc)[2][2][4][2], const Unit& u, int wr, int wc, int fr, int fq) const {
        asm volatile("" : "+v"(fr), "+v"(fq));
        const int row0 = u.pm * BM + wr * 64 + fr, col0 = u.pn * BM + wc * 32 + 8 * fq;
        float rsv[8];
#pragma unroll
        for (int j = 0; j < 8; ++j) rsv[j] = ssq[row0 + (j >> 2) * HALF + (j & 3) * 16];
#pragma unroll
        for (int ai = 0; ai < 2; ++ai)
#pragma unroll
            for (int m = 0; m < 4; ++m) { __builtin_amdgcn_sched_barrier(0);
                const int row = row0 + ai * HALF + m * 16, b = row >> 11, t = row & 2047;
                const float rs = rsqrtf(rsv[ai * 4 + m] * (1.0f / 256.0f) + NORM_EPS) * QSCALE;
#pragma unroll
                for (int bj = 0; bj < 2; ++bj) { const int c = col0 + bj * HALF, h = c / 192, d0 = c - h * 192;
                    f32x4 v0 = acc[ai][bj][m][0] * rs, v1 = acc[ai][bj][m][1] * rs;
                    if (d0 >= 128) { const int g = (d0 - 128) >> 3;
                        const f32x4 cs = *(const f32x4*)(cosT + (size_t)row * 32 + 4 * g), sn = *(const f32x4*)(sinT + (size_t)row * 32 + 4 * g);
                        const f32x4 o1 = v0 * cs - v1 * sn, o2 = v1 * cs + v0 * sn; v0 = o1; v1 = o2; }
                    *(u32x4*)(Q + ((size_t)(b * 4 + h) * 2048 + t) * 192 + d0) = pack8(v0, v1); }
            }
    }
};
struct EpiKN {
    static constexpr bool PERM = true, AFTER_DRAIN = false;
    bf16_t* Kc; const float* sskv;
    DI void operator()(const f32x4 (&acc)[2][2][4][2], const Unit& u, int wr, int wc, int fr, int fq) const {
        asm volatile("" : "+v"(fr), "+v"(fq));
        const int row0 = u.pm * BM + wr * 64 + fr, col0 = u.pn * BM + wc * 32 + 8 * fq;
        float rsv[8];
#pragma unroll
        for (int j = 0; j < 8; ++j) rsv[j] = sskv[row0 + (j >> 2) * HALF + (j & 3) * 16];
#pragma unroll
        for (int ai = 0; ai < 2; ++ai)
#pragma unroll
            for (int m = 0; m < 4; ++m) { __builtin_amdgcn_sched_barrier(0);
                const int row = row0 + ai * HALF + m * 16, b = row >> 11, t = row & 2047;
                const float rs = rsqrtf(rsv[ai * 4 + m] * (1.0f / 128.0f) + NORM_EPS);
#pragma unroll
                for (int bj = 0; bj < 2; ++bj) { const int c = col0 + bj * HALF, h = c >> 7, d0 = c & 127;
                    *(u32x4*)(Kc + ((size_t)(b * 4 + h) * 2048 + t) * 192 + d0) = pack8(acc[ai][bj][m][0] * rs, acc[ai][bj][m][1] * rs); }
            }
    }
};
struct EpiVT {
    static constexpr bool PERM = true, AFTER_DRAIN = false;
    bf16_t* VT; const float* sskv;
    DI void operator()(const f32x4 (&acc)[2][2][4][2], const Unit& u, int wr, int wc, int fr, int fq) const {
        asm volatile("" : "+v"(fr), "+v"(fq));
        const int row0 = u.pm * BM + wr * 64 + fr, col0 = u.pn * BM + wc * 32 + 8 * fq;
        f32x4 s0[2], s1[2];
#pragma unroll
        for (int bj = 0; bj < 2; ++bj) { const f32x4 a = *(const f32x4*)(sskv + col0 + bj * HALF), c = *(const f32x4*)(sskv + col0 + bj * HALF + 4);
#pragma unroll
            for (int j = 0; j < 4; ++j) { s0[bj][j] = rsqrtf(a[j] * (1.0f / 128.0f) + NORM_EPS); s1[bj][j] = rsqrtf(c[j] * (1.0f / 128.0f) + NORM_EPS); } }
#pragma unroll
        for (int ai = 0; ai < 2; ++ai)
#pragma unroll
            for (int m = 0; m < 4; ++m) { __builtin_amdgcn_sched_barrier(0);
                const int row = row0 + ai * HALF + m * 16, h = row >> 7, dv = row & 127;
#pragma unroll
                for (int bj = 0; bj < 2; ++bj) { const int tok = col0 + bj * HALF, b = tok >> 11, t = tok & 2047;
                    *(u32x4*)(VT + ((size_t)(b * 4 + h) * 128 + dv) * 2048 + t) = pack8(acc[ai][bj][m][0] * s0[bj], acc[ai][bj][m][1] * s1[bj]); }
            }
    }
};

template <class Epi, class Sched, bool STAMP = false>
__device__ __forceinline__ void gemm_phase(PG8_LAS unsigned char* lds, const Gemm g, const Sched& S, const Epi& E, unsigned long long* stamps, int wid_s) {
    const int tid = ptid(wid_s), wid = wid_s, lane = tid & 63, wr = wid >> 2, wc = wid & 3, fr = lane & 15, fq = lane >> 4;
    const int K = g.K, nt = K / BK;
    int ts_lo = 0, ts_hi = 0, nts = 0; const unsigned long long rt_entry = STAMP ? (unsigned long long)wall_clock64() : 0ull;
#define PG8_STAMP() do { if (STAMP && wid == 0 && nts < 64) { const unsigned long long _c = (unsigned long long)clock64(); \
        ts_lo = (lane == nts) ? (int)(unsigned)_c : ts_lo; ts_hi = (lane == nts) ? (int)(unsigned)(_c >> 32) : ts_hi; ++nts; } } while (0)
    PG8_STAMP();
    unsigned voffA[2], voffB[2];
#pragma unroll
    for (int i = 0; i < 2; ++i) { int R, C; stage_rc(tid * 16 + i * 8192, R, C); const int Rb = Epi::PERM ? ((R & ~31) + perm32(R & 31)) : R;
        voffA[i] = (unsigned)(R * g.lda + C) * 2u; voffB[i] = (unsigned)(Rb * g.ldb + C) * 2u; }
    const size_t kstep = (size_t)(BK * 2);
    const size_t hsA = (size_t)HALF * g.lda * 2, hsB = (size_t)HALF * g.ldb * 2;
    const size_t tsA = 2 * hsA, tsB = 2 * hsB;
    const unsigned ldsw = (unsigned)wid * 1024u;
    const int aoff = lds_byte(wr * 64 + fr, fq * 8), boff = lds_byte(wc * 32 + fr, fq * 8);
#define PG8_SA(b, h) (((b) * 2 + (h)) * HTB)
#define PG8_SB(b, h) ((4 + (b) * 2 + (h)) * HTB)
#define PG8_STAGE(bufoff, gbase, voff) do { _Pragma("unroll") for (int _i = 0; _i < 2; ++_i) \
        __builtin_amdgcn_global_load_lds((const unsigned*)((const char*)(gbase) + (voff)[_i]), (PG8_LAS unsigned*)(lds + (bufoff) + ldsw + _i * 8192), 16, 0, 0); } while (0)
#define PG8_LDA(dst, b, h) do { _Pragma("unroll") for (int m = 0; m < 4; ++m) _Pragma("unroll") for (int k = 0; k < 2; ++k) dst[m][k] = *(const PG8_LAS bf16x8*)(lds + PG8_SA(b, h) + aoff + m * 2048 + k * 1024); } while (0)
#define PG8_LDB(dst, b, h) do { _Pragma("unroll") for (int n = 0; n < 2; ++n) _Pragma("unroll") for (int k = 0; k < 2; ++k) dst[n][k] = *(const PG8_LAS bf16x8*)(lds + PG8_SB(b, h) + boff + n * 2048 + k * 1024); } while (0)
#define PG8_MMA(ai, bj, At, Bt) do { __builtin_amdgcn_s_setprio(1); _Pragma("unroll") for (int m = 0; m < 4; ++m) _Pragma("unroll") for (int n = 0; n < 2; ++n) _Pragma("unroll") for (int k = 0; k < 2; ++k) \
        acc[ai][bj][m][n] = __builtin_amdgcn_mfma_f32_16x16x32_bf16(Bt[n][k], At[m][k], acc[ai][bj][m][n], 0, 0, 0); __builtin_amdgcn_s_setprio(0); } while (0)
#define PG8_WAIT_V(n) asm volatile("s_waitcnt vmcnt(" #n ")" ::: "memory")
#define PG8_WAIT_L(n) asm volatile("s_waitcnt lgkmcnt(" #n ")" ::: "memory")
#define PG8_BAR __builtin_amdgcn_s_barrier()
#define PG8_SCHED __builtin_amdgcn_sched_barrier(0)
    Unit cur, nxt; int ui = 0;
    if (!S.next(0, cur)) return;
    f32x4 acc[2][2][4][2];
#pragma unroll
    for (int a = 0; a < 2; ++a)
#pragma unroll
        for (int b = 0; b < 2; ++b)
#pragma unroll
            for (int m = 0; m < 4; ++m)
#pragma unroll
                for (int n = 0; n < 2; ++n) acc[a][b][m][n] = (f32x4){0.f, 0.f, 0.f, 0.f};
    bf16x8 At[4][2], B0[2][2], B1[2][2];
    const char* cA = (const char*)g.A + (size_t)cur.pm * tsA; const char* cB = (const char*)g.Bt + (size_t)cur.pn * tsB;
    S.a_ready(cur);
    PG8_STAGE(PG8_SB(0, 0), cB, voffB); PG8_STAGE(PG8_SA(0, 0), cA, voffA); PG8_STAGE(PG8_SB(0, 1), cB + hsB, voffB); PG8_STAGE(PG8_SA(0, 1), cA + hsA, voffA);
    if (wr == 1) PG8_BAR;
    PG8_WAIT_V(4); PG8_BAR;
    PG8_STAGE(PG8_SB(1, 0), cB + kstep, voffB); PG8_STAGE(PG8_SA(1, 0), cA + kstep, voffA); PG8_STAGE(PG8_SB(1, 1), cB + hsB + kstep, voffB);
    PG8_WAIT_V(6); PG8_BAR;
    PG8_STAMP();
    for (;;) {
        const bool has_next = S.next(ui + 1, nxt);
        const char* nA = has_next ? (const char*)g.A + (size_t)nxt.pm * tsA : cA; const char* nB = has_next ? (const char*)g.Bt + (size_t)nxt.pn * tsB : cB;
        for (int t = 0; t < nt; t += 2) {
            const bool last = (t == nt - 2);
            const char* a1 = cA + (size_t)(t + 1) * kstep;
            const char* a2 = last ? nA : cA + (size_t)(t + 2) * kstep; const char* b2 = last ? nB : cB + (size_t)(t + 2) * kstep;
            const char* a3 = a2 + kstep; const char* b3 = b2 + kstep;
            if (last && has_next) S.a_ready(nxt);
            PG8_LDB(B0, 0, 0); PG8_SCHED; PG8_LDA(At, 0, 0); PG8_STAGE(PG8_SA(1, 1), a1 + hsA, voffA);
            PG8_WAIT_L(8); PG8_BAR; PG8_WAIT_L(0); PG8_MMA(0, 0, At, B0); PG8_BAR; PG8_SCHED;
            PG8_LDB(B1, 0, 1); PG8_STAGE(PG8_SB(0, 0), b2, voffB);
            PG8_BAR; PG8_WAIT_L(0); PG8_MMA(0, 1, At, B1); PG8_BAR;
            PG8_LDA(At, 0, 1); PG8_STAGE(PG8_SA(0, 0), a2, voffA);
            PG8_BAR; PG8_WAIT_L(0); PG8_MMA(1, 0, At, B0); PG8_BAR; PG8_SCHED;
            PG8_STAGE(PG8_SB(0, 1), b2 + hsB, voffB);
            PG8_WAIT_V(6); PG8_BAR; PG8_MMA(1, 1, At, B1); PG8_BAR;
            PG8_LDB(B0, 1, 0); PG8_SCHED; PG8_LDA(At, 1, 0); PG8_STAGE(PG8_SA(0, 1), a2 + hsA, voffA);
            PG8_WAIT_L(8); PG8_BAR; PG8_WAIT_L(0); PG8_MMA(0, 0, At, B0); PG8_BAR; PG8_SCHED;
            PG8_LDB(B1, 1, 1); PG8_STAGE(PG8_SB(1, 0), b3, voffB);
            PG8_BAR; PG8_WAIT_L(0); PG8_MMA(0, 1, At, B1); PG8_BAR;
            PG8_LDA(At, 1, 1); PG8_STAGE(PG8_SA(1, 0), a3, voffA);
            PG8_BAR; PG8_WAIT_L(0); PG8_MMA(1, 0, At, B0); PG8_BAR; PG8_SCHED;
            PG8_STAGE(PG8_SB(1, 1), b3 + hsB, voffB);
            PG8_WAIT_V(6); PG8_BAR; PG8_MMA(1, 1, At, B1); PG8_BAR;
        }
        PG8_STAMP();
        if constexpr (!Epi::AFTER_DRAIN) { E(acc, cur, wr, wc, fr, fq); S.done(cur); }
        PG8_STAMP();
        if (!has_next) break;
#pragma unroll
        for (int a = 0; a < 2; ++a)
#pragma unroll
            for (int b = 0; b < 2; ++b)
#pragma unroll
                for (int m = 0; m < 4; ++m)
#pragma unroll
                    for (int n = 0; n < 2; ++n) acc[a][b][m][n] = (f32x4){0.f, 0.f, 0.f, 0.f};
        cur = nxt; cA = nA; cB = nB; ++ui;
    }
    PG8_WAIT_V(0);
    if (wr == 0) PG8_BAR;
    PG8_BAR;
    if constexpr (Epi::AFTER_DRAIN) { E.fused(acc, cur, wr, wc, fr, fq, lds, wid, lane); S.done(cur); }
    PG8_STAMP();
    if (STAMP && wid == 0) { stamps[lane] = lane < nts ? (((unsigned long long)(unsigned)ts_hi << 32) | (unsigned)ts_lo) : 0ull;
        if (lane == 62) stamps[62] = rt_entry; if (lane == 63) stamps[63] = (unsigned long long)wall_clock64(); }
#undef PG8_STAMP
#undef PG8_SA
#undef PG8_SB
#undef PG8_STAGE
#undef PG8_LDA
#undef PG8_LDB
#undef PG8_MMA
#undef PG8_WAIT_V
#undef PG8_WAIT_L
#undef PG8_BAR
#undef PG8_SCHED
}
}
using pg8::bf16_t; using pg8::bf16x8; using pg8::f32x4; using pg8::u32x4;
typedef __attribute__((address_space(3))) unsigned char lds_u8;

struct Params {
    const float* x; const int* pos; const float* g_pre; const float* w_in; const float* g_q; const float* w_uq; const float* g_kv; const float* w_ukv;
    const float* mu; const float* w0; const float* w2; const float* a0; const float* a2; const float* k_k; const float* k_a; const float* r_k;
    const float* ln_g; const float* ln_b; const float* w_out; const float* g_post; float* out; unsigned char* ws;
};

DI int map_in(int n) {
    if (n < 448) return n;
    if (n < 512) return -1;
    if (n < 2048) return n - 64;
    if (n < 2176) return n - 64;
    if (n < 2304) return -1;
    return n - 192;
}
DI int map_q(int n) {
    const int h = n / 192, d = n - h * 192;
    if (d < 128) return n;
    const int j = d - 128, g = j >> 3, i = j & 7, orig = (i < 4) ? (4 * g + i) : (32 + 4 * g + (i - 4));
    return h * 192 + 128 + orig;
}
DI void wconv_tile(int tid, float* tl, int mode, int tn, int tk, const float* src, int ld, int Ksrc, int Kdst, const float* gain, bf16_t* dst) {
    const int n0 = tn * 64, k0 = tk * 64;
#pragma unroll
    for (int e = 0; e < 8; ++e) { const int idx = tid + 512 * e, kk = idx >> 6, nn = idx & 63, n = n0 + nn, k = k0 + kk;
        int sc;
        if (mode == 0) sc = map_in(n); else if (mode == 1) sc = map_q(n); else if (mode == 2) sc = (n >> 7) * 256 + (n & 127); else if (mode == 3) sc = (n >> 7) * 256 + 128 + (n & 127); else sc = n;
        float v = 0.f;
        if (k < Ksrc && sc >= 0) { v = src[(size_t)k * ld + sc]; if (gain) v *= gain[k]; }
        tl[kk * 65 + nn] = v; }
    __syncthreads();
#pragma unroll
    for (int e = 0; e < 8; ++e) { const int idx = tid + 512 * e, nn = idx >> 6, kk = idx & 63;
        const float v = tl[kk * 65 + nn];
        dst[(size_t)(n0 + nn) * Kdst + k0 + kk] = (bf16_t)(pk_bf16(v, 0.f) & 0xffffu); }
    __syncthreads();
}
DI void phase0(const Params& p, float* tl, int wid_s) {
    const int tid = ptid(wid_s), lane = tid & 63, bid = blockIdx.x, G = gridDim.x;
    unsigned char* ws = p.ws;
    for (int i = bid; i < 832 + 48 + 32 + 32 + 256; i += G) {
        if (i < 832) wconv_tile(tid, tl, 0, i >> 4, i & 15, p.w_in, DIN, 1024, 1024, nullptr, (bf16_t*)(ws + OFF_WIN));
        else if (i < 880) { const int j = i - 832; wconv_tile(tid, tl, 1, j >> 2, j & 3, p.w_uq, 768, 256, 256, p.g_q, (bf16_t*)(ws + OFF_WUQ)); }
        else if (i < 912) { const int j = i - 880; wconv_tile(tid, tl, 2, j >> 2, j & 3, p.w_ukv, 1024, 128, 256, p.g_kv, (bf16_t*)(ws + OFF_WKN)); }
        else if (i < 944) { const int j = i - 912; wconv_tile(tid, tl, 3, j >> 2, j & 3, p.w_ukv, 1024, 128, 256, p.g_kv, (bf16_t*)(ws + OFF_WV)); }
        else { const int j = i - 944; wconv_tile(tid, tl, 4, j >> 4, j & 15, p.w_out, 1024, 1024, 1024, nullptr, (bf16_t*)(ws + OFF_WOUT)); }
    }
    { float* ss = (float*)(ws + OFF_SS); for (int i = bid * 512 + tid; i < 3 * M; i += G * 512) ss[i] = 0.f; }
    { float* cs = (float*)(ws + OFF_ROPE); float* sn = cs + (size_t)M * 32;
      const float inv = powf(10000.0f, -(float)(2 * (tid & 31)) * (1.0f / 64.0f));
      for (int i = bid * 512 + tid; i < M * 32; i += G * 512) { const int m = i >> 5;
          const float ang = (float)p.pos[m] * inv;
          float rev = ang * 0.15915494309189535f; rev -= rintf(rev);
          cs[i] = __builtin_amdgcn_cosf(rev); sn[i] = __builtin_amdgcn_sinf(rev); } }
    { bf16_t* U = (bf16_t*)(ws + OFF_U); const int gw = bid * 8 + (tid >> 6), nw = G * 8;
      f32x4 g[4];
#pragma unroll
      for (int i = 0; i < 4; ++i) g[i] = *(const f32x4*)(p.g_pre + (lane + 64 * i) * 4);
      for (int row = gw; row < M; row += nw) { const float* xr = p.x + (size_t)row * D; f32x4 v[4]; float ss = 0.f;
#pragma unroll
          for (int i = 0; i < 4; ++i) { v[i] = __builtin_nontemporal_load((const f32x4*)(xr + (lane + 64 * i) * 4)); ss += v[i][0] * v[i][0] + v[i][1] * v[i][1] + v[i][2] * v[i][2] + v[i][3] * v[i][3]; }
          ss = sum16(ss); ss += xorl(ss, lane, 16); ss += xorl(ss, lane, 32);
          const float rs = rsqrtf(ss * (1.0f / 1024.0f) + NORM_EPS);
#pragma unroll
          for (int i = 0; i < 4; ++i) { u32x2 w; w.x = pk_bf16(v[i][0] * rs * g[i][0], v[i][1] * rs * g[i][1]); w.y = pk_bf16(v[i][2] * rs * g[i][2], v[i][3] * rs * g[i][3]);
              *(u32x2*)(U + (size_t)row * D + (lane + 64 * i) * 4) = w; } } }
}
DI void phase_krope(const Params& p, int wid_s) {
    const unsigned char* ws = p.ws; const bf16_t* P = (const bf16_t*)(ws + OFF_P); bf16_t* Kc = (bf16_t*)(p.ws + OFF_K);
    const float* cs = (const float*)(ws + OFF_ROPE); const float* sn = cs + (size_t)M * 32;
    for (int i = blockIdx.x * 512 + ptid(wid_s); i < M * 8; i += gridDim.x * 512) { const int m = i >> 3, g = i & 7, b = m >> 11, t = m & 2047;
        const u32x2 a = *(const u32x2*)(P + (size_t)m * NP + C_KR + 4 * g), c = *(const u32x2*)(P + (size_t)m * NP + C_KR + 32 + 4 * g);
        const f32x4 x1 = {bf_lo(a.x), bf_hi(a.x), bf_lo(a.y), bf_hi(a.y)}, x2 = {bf_lo(c.x), bf_hi(c.x), bf_lo(c.y), bf_hi(c.y)};
        const f32x4 co = *(const f32x4*)(cs + (size_t)m * 32 + 4 * g), si = *(const f32x4*)(sn + (size_t)m * 32 + 4 * g);
        const u32x4 w = pg8::pack8(x1 * co - x2 * si, x2 * co + x1 * si);
#pragma unroll
        for (int h = 0; h < 4; ++h) *(u32x4*)(Kc + ((size_t)(b * 4 + h) * 2048 + t) * 192 + 128 + 8 * g) = w; }
}
DI void phase_final(const Params& p, int wid_s, int row0, int nrows, int nw, int gw) {
    const int tid = ptid(wid_s), lane = tid & 63; const bf16_t* O = (const bf16_t*)(p.ws + OFF_OUT); const float* sso = (const float*)(p.ws + OFF_SS) + 2 * M;
    f32x4 g[4];
#pragma unroll
    for (int i = 0; i < 4; ++i) g[i] = *(const f32x4*)(p.g_post + (lane + 64 * i) * 4);
    for (int row = row0 + gw; row < row0 + nrows; row += nw) { const float rs = rsqrtf(sso[row] * (1.0f / 1024.0f) + NORM_EPS);
#pragma unroll
        for (int i = 0; i < 4; ++i) { const size_t o = (size_t)row * D + (lane + 64 * i) * 4; const f32x4 xv = __builtin_nontemporal_load((const f32x4*)(p.x + o)); const u32x2 ov = *(const u32x2*)(O + o);
            f32x4 r; r[0] = xv[0] + bf_lo(ov.x) * rs * g[i][0]; r[1] = xv[1] + bf_hi(ov.x) * rs * g[i][1]; r[2] = xv[2] + bf_lo(ov.y) * rs * g[i][2]; r[3] = xv[3] + bf_hi(ov.y) * rs * g[i][3];
            __builtin_nontemporal_store(r, (f32x4*)(p.out + o)); } }
}

#define MFMA32(a, b, c) __builtin_amdgcn_mfma_f32_32x32x16_bf16((a), (b), (c), 0, 0, 0)
constexpr int KROW = 400, VROW = 136, KT_BYTES = 64 * KROW, VT_BYTES = 128 * VROW;
constexpr int ATT_K0 = 0, ATT_V0 = 2 * KT_BYTES;


#define VFRAG(vb_, dt_, q_) __builtin_shufflevector(*(const __attribute__((address_space(3))) s16x4*)((vb_) + ((dt_) * 32 + r) * VROW + (((q_) >> 1) * 32 + 16 * ((q_) & 1) + 4 * hh) * 2), \
                                                    *(const __attribute__((address_space(3))) s16x4*)((vb_) + ((dt_) * 32 + r) * VROW + (((q_) >> 1) * 32 + 16 * ((q_) & 1) + 4 * hh) * 2 + 16), 0, 1, 2, 3, 4, 5, 6, 7)
#define PV_BLOCK(vb_) do { bf16x8 vf[2][4]; \
        _Pragma("unroll") for (int q_ = 0; q_ < 4; ++q_) vf[0][q_] = VFRAG(vb_, 0, q_); \
        _Pragma("unroll") for (int dt_ = 0; dt_ < 4; ++dt_) { \
            if (dt_ + 1 < 4) { _Pragma("unroll") for (int q_ = 0; q_ < 4; ++q_) vf[(dt_ + 1) & 1][q_] = VFRAG(vb_, dt_ + 1, q_); } \
            __builtin_amdgcn_sched_barrier(0); \
            _Pragma("unroll") for (int q_ = 0; q_ < 4; ++q_) o[dt_] = MFMA32(vf[dt_ & 1][q_], pf[q_ >> 1][q_ & 1], o[dt_]); \
            __builtin_amdgcn_sched_barrier(0); } } while (0)
DI void attn_item(lds_u8* lds, const Params& p, int bh, int qb, int wid_s) {
    const unsigned char* ws = p.ws;
    const bf16_t* Qg = (const bf16_t*)(ws + OFF_Q) + (size_t)bh * 2048 * 192;
    const unsigned char* Kg = ws + OFF_K + (size_t)bh * 2048 * 384;
    const unsigned char* Vg = ws + OFF_VT + (size_t)bh * 128 * 4096;
    const bf16_t* P = (const bf16_t*)(ws + OFF_P); bf16_t* Y = (bf16_t*)(p.ws + OFF_U);
    const int tid = ptid(wid_s), lane = tid & 63, w = wid_s, r = lane & 31, hh = lane >> 5;
    const int b = bh >> 2, h = bh & 3, qrow = qb * 256 + 32 * w + r;
    const int nkt = 4 * (qb + 1), my_last = qb * 4 + (w >> 1);
    int kdst[3], vsrc[2], vdst[2];
#pragma unroll
    for (int j = 0; j < 3; ++j) { const int c = tid + 512 * j, key = c / 24, part = c - key * 24; kdst[j] = key * KROW + part * 16; }
#pragma unroll
    for (int j = 0; j < 2; ++j) { const int c = tid + 512 * j, dv = c >> 3, part = c & 7; vsrc[j] = dv * 4096 + part * 16; vdst[j] = dv * VROW + part * 16; }
    bf16x8 qf[12];
#pragma unroll
    for (int s = 0; s < 12; ++s) qf[s] = *(const bf16x8*)(Qg + (size_t)qrow * 192 + 16 * s + 8 * hh);
    u32x4 kst[3], vst[2];
#pragma unroll
    for (int j = 0; j < 3; ++j) kst[j] = *(const u32x4*)(Kg + (size_t)(tid + 512 * j) * 16);
#pragma unroll
    for (int j = 0; j < 2; ++j) vst[j] = *(const u32x4*)(Vg + vsrc[j]);
#pragma unroll
    for (int j = 0; j < 3; ++j) *(u32x4*)(lds + ATT_K0 + kdst[j]) = kst[j];
#pragma unroll
    for (int j = 0; j < 2; ++j) { *(u32x2*)(lds + ATT_V0 + vdst[j]) = (u32x2){vst[j].x, vst[j].y}; *(u32x2*)(lds + ATT_V0 + vdst[j] + 8) = (u32x2){vst[j].z, vst[j].w}; }
    __syncthreads();
    f32x16 o[4];
#pragma unroll
    for (int dt = 0; dt < 4; ++dt)
#pragma unroll
        for (int i = 0; i < 16; ++i) o[dt][i] = 0.f;
    float mrow = -1e30f, lsum = 0.f; bf16x8 pf[2][2]; const bool late = w >= 4;
#pragma unroll
    for (int i = 0; i < 2; ++i)
#pragma unroll
        for (int j = 0; j < 2; ++j) pf[i][j] = (bf16x8){0, 0, 0, 0, 0, 0, 0, 0};
    for (int kt = 0; kt < nkt; ++kt) {
        const int cur = kt & 1, nxt = cur ^ 1;
        if (kt + 1 < nkt) {
#pragma unroll
            for (int j = 0; j < 3; ++j) kst[j] = *(const u32x4*)(Kg + (size_t)(kt + 1) * 64 * 384 + (size_t)(tid + 512 * j) * 16);
#pragma unroll
            for (int j = 0; j < 2; ++j) vst[j] = *(const u32x4*)(Vg + (kt + 1) * 128 + vsrc[j]);
        }
        if (late && kt >= 1 && kt - 1 <= my_last) { const lds_u8* vb = lds + ATT_V0 + nxt * VT_BYTES;
            PV_BLOCK(vb);
        }
        if (kt <= my_last) {
            const lds_u8* kb = lds + ATT_K0 + cur * KT_BYTES; const lds_u8* vb = lds + ATT_V0 + cur * VT_BYTES;
            f32x16 st[2];
#pragma unroll
            for (int sub = 0; sub < 2; ++sub)
#pragma unroll
                for (int i = 0; i < 16; ++i) st[sub][i] = 0.f;
            { bf16x8 kf[2][4];
#define KFRAG(g_, j_) (*(const __attribute__((address_space(3))) bf16x8*)(kb + (((g_) / 3) * 32 + r) * KROW + (16 * (((g_) % 3) * 4 + (j_)) + 8 * hh) * 2))
#pragma unroll
              for (int j = 0; j < 4; ++j) kf[0][j] = KFRAG(0, j);
#pragma unroll
              for (int g = 0; g < 6; ++g) {
                  if (g + 1 < 6) {
#pragma unroll
                      for (int j = 0; j < 4; ++j) kf[(g + 1) & 1][j] = KFRAG(g + 1, j); }
                  __builtin_amdgcn_sched_barrier(0);
#pragma unroll
                  for (int j = 0; j < 4; ++j) st[g / 3] = MFMA32(kf[g & 1][j], qf[(g % 3) * 4 + j], st[g / 3]);
                  __builtin_amdgcn_sched_barrier(0); }
#undef KFRAG
            }
            if (kt == my_last) {
#pragma unroll
                for (int sub = 0; sub < 2; ++sub)
#pragma unroll
                    for (int i = 0; i < 16; ++i) { const int key = kt * 64 + sub * 32 + (i & 3) + 8 * (i >> 2) + 4 * hh; if (key > qrow) st[sub][i] = -1e30f; }
            }
            float mx0 = st[0][0], mx1 = st[1][0];
#pragma unroll
            for (int i = 1; i < 16; ++i) { mx0 = fmaxf(mx0, st[0][i]); mx1 = fmaxf(mx1, st[1][i]); }
            float mx = fmaxf(mx0, mx1);
            { const unsigned mb = __builtin_bit_cast(unsigned, mx); const auto sw = __builtin_amdgcn_permlane32_swap(mb, mb, false, false);
              mx = fmaxf(__builtin_bit_cast(float, (unsigned)sw[0]), __builtin_bit_cast(float, (unsigned)sw[1])); }
            if (__builtin_amdgcn_ballot_w64(mx > mrow + 11.5f) != 0ull) {
                const float mnew = fmaxf(mrow, mx), alpha = __builtin_amdgcn_exp2f(mrow - mnew);
                mrow = mnew; lsum *= alpha;
#pragma unroll
                for (int dt = 0; dt < 4; ++dt)
#pragma unroll
                    for (int i = 0; i < 16; ++i) o[dt][i] *= alpha; }
            float ps0 = 0.f, ps1 = 0.f, ps2 = 0.f, ps3 = 0.f;
#pragma unroll
            for (int i = 0; i < 16; i += 2) { st[0][i] = __builtin_amdgcn_exp2f(st[0][i] - mrow); ps0 += st[0][i]; st[0][i + 1] = __builtin_amdgcn_exp2f(st[0][i + 1] - mrow); ps1 += st[0][i + 1];
                                              st[1][i] = __builtin_amdgcn_exp2f(st[1][i] - mrow); ps2 += st[1][i]; st[1][i + 1] = __builtin_amdgcn_exp2f(st[1][i + 1] - mrow); ps3 += st[1][i + 1]; }
            lsum += (ps0 + ps1) + (ps2 + ps3);
#pragma unroll
            for (int sub = 0; sub < 2; ++sub)
#pragma unroll
                for (int s = 0; s < 2; ++s) { u32x4 q; q.x = pk_bf16(st[sub][8 * s], st[sub][8 * s + 1]); q.y = pk_bf16(st[sub][8 * s + 2], st[sub][8 * s + 3]);
                    q.z = pk_bf16(st[sub][8 * s + 4], st[sub][8 * s + 5]); q.w = pk_bf16(st[sub][8 * s + 6], st[sub][8 * s + 7]); pf[sub][s] = __builtin_bit_cast(bf16x8, q); }
            if (!late) {
            PV_BLOCK(vb);

            }
        }
        __syncthreads();
        if (kt + 1 < nkt) {
#pragma unroll
            for (int j = 0; j < 3; ++j) *(u32x4*)(lds + ATT_K0 + nxt * KT_BYTES + kdst[j]) = kst[j];
#pragma unroll
            for (int j = 0; j < 2; ++j) { *(u32x2*)(lds + ATT_V0 + nxt * VT_BYTES + vdst[j]) = (u32x2){vst[j].x, vst[j].y}; *(u32x2*)(lds + ATT_V0 + nxt * VT_BYTES + vdst[j] + 8) = (u32x2){vst[j].z, vst[j].w}; }
        }
        __syncthreads();
    }
    if (late && nkt - 1 <= my_last) { const lds_u8* vb = lds + ATT_V0 + ((nkt - 1) & 1) * VT_BYTES;
            PV_BLOCK(vb);
    }
    __syncthreads();
    lsum += xorl(lsum, lane, 32);
    const float inv = frcp(lsum);
    const size_t m = (size_t)b * 2048 + qrow;
#pragma unroll
    for (int dt = 0; dt < 4; ++dt)
#pragma unroll
        for (int g = 0; g < 4; ++g) { const int dv0 = dt * 32 + 8 * g + 4 * hh;
            const u32x2 zz = *(const u32x2*)(P + m * NP + C_Z + h * 128 + dv0);
            const float y0 = o[dt][4 * g] * inv * silu(bf_lo(zz.x)), y1 = o[dt][4 * g + 1] * inv * silu(bf_hi(zz.x)), y2 = o[dt][4 * g + 2] * inv * silu(bf_lo(zz.y)), y3 = o[dt][4 * g + 3] * inv * silu(bf_hi(zz.y));
            u32x2 wv; wv.x = pk_bf16(y0, y1); wv.y = pk_bf16(y2, y3);
            *(u32x2*)(Y + m * 1024 + h * 128 + dv0) = wv; }
}

constexpr int CL = 16, NCH = T / CL;
constexpr int Q_RAW = 0, RAW_STRIDE = 24576;
constexpr int R_W = 0, R_NK = 4096, R_B = 8192, R_KP = 12288, R_R = 16384, R_IW = 20480;
constexpr int Q_VF = 2 * RAW_STRIDE, Q_BON = Q_VF + 16384, Q_A = Q_BON + 256, Q_XW = Q_A + 4096, Q_XA = Q_XW + 2304, Q_W2T = Q_XA + 2304, Q_A2T = Q_W2T + 9216, Q_P2 = Q_A2T + 9216;
constexpr int P2_NT = 0, P2_RT = 2304, P2_BT = 4608, P2_KT = 6912, P2_BKDT = 9216, P2_SAV = 14336, P2_DL = 19456, P2_MBT = 19712, P2_MKT = 20736, P2_PT = 22016, P2_STRIDE = 23296;
constexpr int Q_XV = Q_P2 + 2 * P2_STRIDE, Q_YS = Q_XV + 5120, Q_S0B = Q_YS + 2 * 16 * 272, CSCAN_LDS = Q_S0B + 9216;
static_assert(CSCAN_LDS <= LDS_BYTES, "scan LDS map");
#define LDSP(TY, ptr) ((__attribute__((address_space(3))) TY*)(ptr))
#define MFMA16(a, b, c) __builtin_amdgcn_mfma_f32_16x16x32_bf16((a), (b), (c), 0, 0, 0)
DI unsigned short bf1(float v) { return (unsigned short)(pk_bf16(v, 0.f) & 0xffffu); }
DI float fast_tanh(float x) { return 1.0f - 2.0f * frcp(1.0f + __expf(2.0f * x)); }
DI f32x4 cvt4bf(const u32x2 a) { return (f32x4){bf_lo(a.x), bf_hi(a.x), bf_lo(a.y), bf_hi(a.y)}; }
DI u32x2 pack4(const f32x4 v) { u32x2 w; w.x = pk_bf16(v[0], v[1]); w.y = pk_bf16(v[2], v[3]); return w; }
DI float hsum4(const f32x4 a) { return (a[0] + a[1]) + (a[2] + a[3]); }

struct P1Raw { u32x2 cr, ck, cv, cw, ca, qr, qk, qv, qw, qa; f32x4 mu_r, mu_k, mu_v, mu_w, mu_a; };
struct P1Mid { f32x4 rs, ks, kkg, kag, rkg; };

DI void p1_load(P1Raw& R, const Params& p, int b, int h, int q, int ptid) {
    const bf16_t* P = (const bf16_t*)(p.ws + OFF_P);
    const int t = q * CL + (ptid >> 4), c4 = (ptid & 15) * 4, hc = h * 64 + c4; const bf16_t* pr = P + ((size_t)b * 2048 + t) * NP;
    R.cr = *(const u32x2*)(pr + C_R + hc); R.ck = *(const u32x2*)(pr + C_K + hc); R.cv = *(const u32x2*)(pr + C_V + hc); R.cw = *(const u32x2*)(pr + C_XW + c4); R.ca = *(const u32x2*)(pr + C_XA + c4);
    const u32x2 z = {0u, 0u}; R.qr = R.qk = R.qv = R.qw = R.qa = z;
    if (t > 0) { R.qr = *(const u32x2*)(pr - NP + C_R + hc); R.qk = *(const u32x2*)(pr - NP + C_K + hc); R.qv = *(const u32x2*)(pr - NP + C_V + hc); R.qw = *(const u32x2*)(pr - NP + C_XW + c4); R.qa = *(const u32x2*)(pr - NP + C_XA + c4); }
}
DI void p1_load_mu(P1Raw& R, const Params& p, int h, int ptid) { const int c4 = (ptid & 15) * 4, hc = h * 64 + c4;
    R.mu_r = *(const f32x4*)(p.mu + hc); R.mu_k = *(const f32x4*)(p.mu + 512 + hc); R.mu_v = *(const f32x4*)(p.mu + 1024 + hc); R.mu_w = *(const f32x4*)(p.mu + 1536 + c4); R.mu_a = *(const f32x4*)(p.mu + 1600 + c4); }
DI void p1_a(P1Mid& Mi, lds_u8* lds, const Params& p, int h, const P1Raw& R, int q, int ptid, int lane) {
    const int pw = ptid >> 6, t = ptid >> 4, c4 = (ptid & 15) * 4;
    { const int hc = h * 64 + c4; Mi.kkg = *(const f32x4*)(p.k_k + hc); Mi.kag = *(const f32x4*)(p.k_a + hc); Mi.rkg = *(const f32x4*)(p.r_k + hc); }
    lds_u8* raw = lds + Q_RAW + (q & 1) * RAW_STRIDE;
    const f32x4 cr = cvt4bf(R.cr), ck = cvt4bf(R.ck), cv = cvt4bf(R.cv), cw = cvt4bf(R.cw), ca = cvt4bf(R.ca);
    const f32x4 rs = cr + (cvt4bf(R.qr) - cr) * R.mu_r, ks = ck + (cvt4bf(R.qk) - ck) * R.mu_k, vs = cv + (cvt4bf(R.qv) - cv) * R.mu_v;
    f32x4 xw = cw + (cvt4bf(R.qw) - cw) * R.mu_w; const f32x4 xa = ca + (cvt4bf(R.qa) - ca) * R.mu_a;
    *LDSP(f32x4, raw + R_R + (t * 64 + c4) * 4) = rs;
    *LDSP(f32x4, lds + Q_VF + ((q & 3) * 1024 + t * 64 + c4) * 4) = vs;
#pragma unroll
    for (int i = 0; i < 4; ++i) xw[i] = fast_tanh(xw[i]);
    *LDSP(u32x2, lds + Q_XW + t * 144 + c4 * 2) = pack4(xw); *LDSP(u32x2, lds + Q_XA + t * 144 + c4 * 2) = pack4(xa);
    Mi.rs = rs; Mi.ks = ks;
}
DI void p1_b(lds_u8* lds, const float w0, const float a0, const P1Mid& Mi, int q, int ptid, int lane) {
    const int pw = ptid >> 6, t = ptid >> 4, c4 = (ptid & 15) * 4, fr = lane & 15, fq = lane >> 4;
    lds_u8* raw = lds + Q_RAW + (q & 1) * RAW_STRIDE;
    bf16x8 aw[2], aa[2];
#pragma unroll
    for (int s = 0; s < 2; ++s) { aw[s] = *LDSP(const bf16x8, lds + Q_XW + (4 * pw + (fr & 3)) * 144 + (32 * s + 8 * fq) * 2); aa[s] = *LDSP(const bf16x8, lds + Q_XA + (4 * pw + (fr & 3)) * 144 + (32 * s + 8 * fq) * 2); }
    f32x4 selw = {0.f, 0.f, 0.f, 0.f}, sela = {0.f, 0.f, 0.f, 0.f};
#pragma unroll
    for (int nt = 0; nt < 4; ++nt) { f32x4 cwv = {0.f, 0.f, 0.f, 0.f}, cav = {0.f, 0.f, 0.f, 0.f};
#pragma unroll
        for (int s = 0; s < 2; ++s) { const bf16x8 bw = *LDSP(const bf16x8, lds + Q_W2T + (nt * 16 + fr) * 144 + (32 * s + 8 * fq) * 2), ba = *LDSP(const bf16x8, lds + Q_A2T + (nt * 16 + fr) * 144 + (32 * s + 8 * fq) * 2);
            cwv = MFMA16(aw[s], bw, cwv); cav = MFMA16(aa[s], ba, cav); }
        const bool mine = (fq == nt);
#pragma unroll
        for (int i = 0; i < 4; ++i) { selw[i] = mine ? cwv[i] : selw[i]; sela[i] = mine ? cav[i] : sela[i]; } }
    { const int n = fq * 16 + fr;
#pragma unroll
      for (int i = 0; i < 4; ++i) { const int tt = 4 * pw + i;
          const float yv = -(selw[i] + w0), sp = fmaxf(yv, 0.f) + __logf(1.0f + __expf(-fabsf(yv)));
          const float lw = -__expf(-sp - 0.5f);
          *LDSP(float, raw + R_W + (tt * 64 + n) * 4) = __expf(lw); *LDSP(float, raw + R_IW + (tt * 64 + n) * 4) = __expf(-lw);
          *LDSP(float, lds + Q_A + (tt * 64 + n) * 4) = frcp(1.0f + __expf(-(sela[i] + a0))); } }
    { const f32x4 a = *LDSP(const f32x4, lds + Q_A + (t * 64 + c4) * 4);
      f32x4 kk = Mi.ks * Mi.kkg; const float invn = frcp(fmaxf(sqrtf(sum16(hsum4(kk * kk))), 1e-12f)); kk = kk * invn;
      const f32x4 bb = kk * a, kp = Mi.ks * (1.0f + (a - 1.0f) * Mi.kag);
      const float bon = sum16(hsum4(Mi.rs * kp * Mi.rkg));
      *LDSP(f32x4, raw + R_NK + (t * 64 + c4) * 4) = -kk; *LDSP(f32x4, raw + R_B + (t * 64 + c4) * 4) = bb; *LDSP(f32x4, raw + R_KP + (t * 64 + c4) * 4) = kp;
      if ((ptid & 15) == 0) *LDSP(float, lds + Q_BON + ((q & 3) * 16 + t) * 4) = bon; }
}
DI void p2_compute(lds_u8* lds, int q, int role, int lane) {
    const lds_u8* raw = lds + Q_RAW + (q & 1) * RAW_STRIDE; lds_u8* o = lds + Q_P2 + (q & 1) * P2_STRIDE; const int c = lane;
    if (role == 0) {
        float dprev = 1.0f; unsigned vb[8];
#pragma unroll
        for (int t = 0; t < 16; ++t) { const float d = dprev * *LDSP(const float, raw + R_W + (t * 64 + c) * 4);
            *LDSP(unsigned short, o + P2_NT + t * 144 + c * 2) = bf1(*LDSP(const float, raw + R_NK + (t * 64 + c) * 4) * dprev);
            *LDSP(unsigned short, o + P2_RT + t * 144 + c * 2) = bf1(*LDSP(const float, raw + R_R + (t * 64 + c) * 4) * d); dprev = d; }
#pragma unroll
        for (int t = 0; t < 16; t += 2) vb[t >> 1] = pk_bf16(*LDSP(const float, lds + Q_VF + ((q & 3) * 1024 + t * 64 + c) * 4), *LDSP(const float, lds + Q_VF + ((q & 3) * 1024 + (t + 1) * 64 + c) * 4));
        *LDSP(u32x4, o + P2_SAV + c * 80 + 32) = (u32x4){vb[0], vb[1], vb[2], vb[3]}; *LDSP(u32x4, o + P2_SAV + c * 80 + 48) = (u32x4){vb[4], vb[5], vb[6], vb[7]};
    } else {
        const int src = (role == 1) ? R_B : R_KP, dst = (role == 1) ? P2_BT : P2_KT; float iv = 1.0f, v[16]; unsigned wb[8];
#pragma unroll
        for (int t = 0; t < 16; ++t) { iv *= *LDSP(const float, raw + R_IW + (t * 64 + c) * 4); v[t] = *LDSP(const float, raw + src + (t * 64 + c) * 4) * iv;
            *LDSP(unsigned short, o + dst + t * 144 + c * 2) = bf1(v[t]); }
        const float dl = frcp(iv);
#pragma unroll
        for (int t = 0; t < 16; t += 2) wb[t >> 1] = pk_bf16(v[t] * dl, v[t + 1] * dl);
        const int off = (role == 1) ? 0 : 32;
        *LDSP(u32x4, o + P2_BKDT + c * 80 + off) = (u32x4){wb[0], wb[1], wb[2], wb[3]}; *LDSP(u32x4, o + P2_BKDT + c * 80 + off + 16) = (u32x4){wb[4], wb[5], wb[6], wb[7]};
        if (role == 2) *LDSP(float, o + P2_DL + c * 4) = dl;
    }
}
DI void p3_products(lds_u8* lds, int q, int pw, int lane) {
    lds_u8* o = lds + Q_P2 + (q & 1) * P2_STRIDE; const int fr = lane & 15, fq = lane >> 4;
    const int ao = (pw & 1) ? P2_KT : P2_BT, bo = (pw & 2) ? P2_RT : P2_NT;
    f32x4 acc = {0.f, 0.f, 0.f, 0.f};
#pragma unroll
    for (int s = 0; s < 2; ++s) { const bf16x8 a = *LDSP(const bf16x8, o + ao + fr * 144 + (32 * s + 8 * fq) * 2), bb = *LDSP(const bf16x8, o + bo + fr * 144 + (32 * s + 8 * fq) * 2); acc = MFMA16(a, bb, acc); }
#pragma unroll
    for (int i = 0; i < 4; ++i) { const int j = 4 * fq + i; const bool keep = (pw & 2) ? (j <= fr) : (j < fr); acc[i] = keep ? acc[i] : 0.f; }
    if (pw == 0) *LDSP(f32x4, o + P2_MBT + fr * 64 + fq * 16) = acc;
    else if (pw == 1) *LDSP(u32x2, o + P2_MKT + fr * 80 + 32 + fq * 8) = pack4(acc);
    else *LDSP(u32x2, o + P2_PT + fr * 80 + (pw == 3 ? 32 : 0) + fq * 8) = pack4(acc);
}
DI void solve_sa(lds_u8* lds, int c, int lane) {
    lds_u8* o = lds + Q_P2 + (c & 1) * P2_STRIDE; float sa[16];
#pragma unroll
    for (int g = 0; g < 4; ++g) { const f32x4 x = *LDSP(const f32x4, lds + Q_XV + lane * 80 + g * 16); sa[4 * g] = x[0]; sa[4 * g + 1] = x[1]; sa[4 * g + 2] = x[2]; sa[4 * g + 3] = x[3]; }
    f32x4 mr[2][4];
    mr[1][0] = *LDSP(const f32x4, o + P2_MBT + 64);
#pragma unroll
    for (int t = 1; t < 16; ++t) {
        if (t + 1 < 16) {
#pragma unroll
            for (int g = 0; g < (t + 4) / 4; ++g) mr[(t + 1) & 1][g] = *LDSP(const f32x4, o + P2_MBT + (t + 1) * 64 + g * 16); }
        float acc = sa[t];
#pragma unroll
        for (int g = 0; g < (t + 3) / 4; ++g) {
#pragma unroll
            for (int i = 0; i < 4; ++i) if (4 * g + i < t) acc += sa[4 * g + i] * mr[t & 1][g][i]; }
        sa[t] = acc;
        __builtin_amdgcn_sched_barrier(0);
    }
    *LDSP(u32x4, o + P2_SAV + lane * 80) = (u32x4){pk_bf16(sa[0], sa[1]), pk_bf16(sa[2], sa[3]), pk_bf16(sa[4], sa[5]), pk_bf16(sa[6], sa[7])};
    *LDSP(u32x4, o + P2_SAV + lane * 80 + 16) = (u32x4){pk_bf16(sa[8], sa[9]), pk_bf16(sa[10], sa[11]), pk_bf16(sa[12], sa[13]), pk_bf16(sa[14], sa[15])};
}
DI void post_chunk(lds_u8* lds, const Params& p, const f32x4 lng, const f32x4 lnb, const u32x2 zraw, int b, int h, int c, int td) {
    bf16_t* Y = (bf16_t*)(p.ws + OFF_U);
    const int t = td >> 4, c4 = (td & 15) * 4, hc = h * 64 + c4; const size_t m = (size_t)b * 2048 + c * CL + t;
    const f32x4 y = *LDSP(const f32x4, lds + Q_YS + (c & 1) * (16 * 272) + t * 272 + c4 * 4), vs = *LDSP(const f32x4, lds + Q_VF + ((c & 3) * 1024 + t * 64 + c4) * 4); const float bon = *LDSP(const float, lds + Q_BON + ((c & 3) * 16 + t) * 4);
    const float mean = sum16(hsum4(y)) * (1.0f / 64.0f); const f32x4 d = y - mean; const float rstd = rsqrtf(sum16(hsum4(d * d)) * (1.0f / 64.0f) + GN_EPS);
    const f32x4 z = cvt4bf(zraw); f32x4 o = d * rstd * lng + lnb + bon * vs;
#pragma unroll
    for (int i = 0; i < 4; ++i) o[i] *= silu(z[i]);
    *(u32x2*)(Y + m * 1024 + 512 + hc) = pack4(o);
}

DI void scan_unit(lds_u8* lds, const Params& p, int bh, int wid_s) {
    const int tid = ptid(wid_s), lane = tid & 63, wv = wid_s;
    const int b = bh >> 3, h = bh & 7;
    const bf16_t* P = (const bf16_t*)(p.ws + OFF_P);
#pragma unroll 1
    for (int j0 = 0; j0 < 4; j0 += 4) { f32x4 wv[4];
#pragma unroll
        for (int j = 0; j < 4; ++j) { const int ch = tid + 512 * (j0 + j), mat = ch >> 10, k = (ch >> 4) & 63, n4 = (ch & 15) * 4; wv[j] = *(const f32x4*)((mat ? p.a2 : p.w2) + (size_t)k * 512 + h * 64 + n4); }
#pragma unroll
        for (int j = 0; j < 4; ++j) { const int ch = tid + 512 * (j0 + j), mat = ch >> 10, k = (ch >> 4) & 63, n4 = (ch & 15) * 4;
#pragma unroll
            for (int i = 0; i < 4; ++i) *LDSP(unsigned short, lds + (mat ? Q_A2T : Q_W2T) + (n4 + i) * 144 + k * 2) = bf1(wv[j][i]); } }
    for (int i = tid; i < 9216 / 4; i += 512) *LDSP(unsigned, lds + Q_S0B + i * 4) = 0u;
    for (int i = tid; i < 2 * (5120 / 4); i += 512) { const int par = i / 1280, j = i - par * 1280; *LDSP(unsigned, lds + Q_P2 + par * P2_STRIDE + P2_SAV + j * 4) = 0u; }
    for (int i = tid; i < 2 * (1280 / 4); i += 512) { const int par = i / 320, j = i - par * 320; *LDSP(unsigned, lds + Q_P2 + par * P2_STRIDE + P2_MKT + j * 4) = 0u; }
    __syncthreads();
    const int pw = wv - 4;
    P1Raw R; P1Mid Mi; u32x2 zpre = {0u, 0u}; f32x4 lng = {0.f, 0.f, 0.f, 0.f}, lnb = lng; const float w0l = p.w0[h * 64 + lane], a0l = p.a0[h * 64 + lane];
    if (wv >= 4) { const int ptd0 = tid - 256, c4 = (ptd0 & 15) * 4, hc = h * 64 + c4;
        p1_load(R, p, b, h, 0, ptd0); p1_load_mu(R, p, h, ptd0);
    }
    f32x4 sacc[2] = {{0.f, 0.f, 0.f, 0.f}, {0.f, 0.f, 0.f, 0.f}}, yacc = {0.f, 0.f, 0.f, 0.f};
    for (int c = -2; c < NCH; ++c) {
        int lane_l = lane; asm volatile("" : "+v"(lane_l));
        const int fr = lane_l & 15, fq = lane_l >> 4, ptd = (wv - 4) * 64 + lane_l, td = wv * 64 + lane_l;
        const lds_u8* o = lds + Q_P2 + (c & 1) * P2_STRIDE;
        if (wv < 4 && c >= 1) { zpre = *(const u32x2*)(P + ((size_t)b * 2048 + (c - 1) * CL + (td >> 4)) * NP + C_Z + 512 + h * 64 + (td & 15) * 4);
            lng = *(const f32x4*)(p.ln_g + h * 64 + (td & 15) * 4); lnb = *(const f32x4*)(p.ln_b + h * 64 + (td & 15) * 4); }
        if (c >= 0) {
            if (wv < 4) { const int rt = wv; f32x4 acc = {0.f, 0.f, 0.f, 0.f};
#pragma unroll
                for (int s = 0; s < 2; ++s) { const bf16x8 a = *LDSP(const bf16x8, lds + Q_S0B + (rt * 16 + fr) * 144 + (32 * s + 8 * fq) * 2), bb = *LDSP(const bf16x8, o + P2_NT + fr * 144 + (32 * s + 8 * fq) * 2); acc = MFMA16(a, bb, acc); }
                { const bf16x8 a = *LDSP(const bf16x8, o + P2_SAV + (rt * 16 + fr) * 80 + fq * 16), bb = *LDSP(const bf16x8, o + P2_MKT + fr * 80 + fq * 16); acc = MFMA16(a, bb, acc); }
#pragma unroll
                for (int i = 0; i < 4; ++i) *LDSP(float, lds + Q_XV + (rt * 16 + 4 * fq + i) * 80 + fr * 4) = acc[i];
                yacc = (f32x4){0.f, 0.f, 0.f, 0.f};
#pragma unroll
                for (int s = 0; s < 2; ++s) { const bf16x8 a = *LDSP(const bf16x8, lds + Q_S0B + (rt * 16 + fr) * 144 + (32 * s + 8 * fq) * 2), bb = *LDSP(const bf16x8, o + P2_RT + fr * 144 + (32 * s + 8 * fq) * 2); yacc = MFMA16(a, bb, yacc); }
            }
        }
        if (wv >= 4) { if (c + 2 < NCH) p1_a(Mi, lds, p, h, R, c + 2, ptd, lane_l);
            if (c + 3 < NCH) p1_load(R, p, b, h, c + 3, ptd); }
        __syncthreads();
        if (wv == 0) { if (c >= 0) solve_sa(lds, c, lane_l); }
        else if (wv < 4) { if (c + 1 >= 0 && c + 1 < NCH) p2_compute(lds, c + 1, wv - 1, lane_l); }
        else { if (c + 2 < NCH) p1_b(lds, w0l, a0l, Mi, c + 2, ptd, lane_l); }
        __syncthreads();
        if (wv >= 4 && c + 3 < NCH) p1_load_mu(R, p, h, ptd);
        if (c >= 0) {
            if (wv < 4) { const int rt = wv; const bf16x8 a = *LDSP(const bf16x8, o + P2_SAV + (rt * 16 + fr) * 80 + fq * 16), bb = *LDSP(const bf16x8, o + P2_PT + fr * 80 + fq * 16);
                yacc = MFMA16(a, bb, yacc);
                *LDSP(f32x4, lds + Q_YS + (c & 1) * (16 * 272) + fr * 272 + (rt * 16 + 4 * fq) * 4) = yacc; }
            { const int rt = wv >> 1; const bf16x8 a = *LDSP(const bf16x8, o + P2_SAV + (rt * 16 + fr) * 80 + fq * 16);
#pragma unroll
              for (int u = 0; u < 2; ++u) { const int ct = 2 * (wv & 1) + u; const float dl = *LDSP(const float, o + P2_DL + (ct * 16 + fr) * 4);
                  const bf16x8 bb = *LDSP(const bf16x8, o + P2_BKDT + (ct * 16 + fr) * 80 + fq * 16);
                  sacc[u] = MFMA16(a, bb, sacc[u] * dl);
#pragma unroll
                  for (int i = 0; i < 4; ++i) *LDSP(unsigned short, lds + Q_S0B + (rt * 16 + 4 * fq + i) * 144 + (ct * 16 + fr) * 2) = bf1(sacc[u][i]); } }
        }
        if (wv >= 4) { if (c + 1 >= 0 && c + 1 < NCH) p3_products(lds, c + 1, pw, lane_l); }
        else if (c >= 1) post_chunk(lds, p, lng, lnb, zpre, b, h, c - 1, td);
        __syncthreads();
    }
    if (wv < 4) { zpre = *(const u32x2*)(P + ((size_t)b * 2048 + (NCH - 1) * CL + (tid >> 4)) * NP + C_Z + 512 + h * 64 + (tid & 15) * 4);
        lng = *(const f32x4*)(p.ln_g + h * 64 + (tid & 15) * 4); lnb = *(const f32x4*)(p.ln_b + h * 64 + (tid & 15) * 4);
        post_chunk(lds, p, lng, lnb, zpre, b, h, NCH - 1, tid); }
}

__global__ void __launch_bounds__(512) hymba_fwd(Params p) {
    extern __shared__ __attribute__((aligned(16))) unsigned char lds_raw[];
    lds_u8* lds = (lds_u8*)lds_raw;
    cg::grid_group grid = cg::this_grid();
    unsigned char* ws = p.ws; const int G = gridDim.x, bid = blockIdx.x, wid_s = __builtin_amdgcn_readfirstlane(threadIdx.x >> 6);
    float* ss = (float*)(ws + OFF_SS);
    const float* cosT = (const float*)(ws + OFF_ROPE); const float* sinT = cosT + (size_t)M * 32;

    phase0(p, (float*)lds_raw, wid_s);
    grid.sync();
    { pg8::Gemm g{(const bf16_t*)(ws + OFF_U), (const bf16_t*)(ws + OFF_WIN), M, NP, 1024, 1024, 1024}; pg8::StaticOrder S; S.init(M, NP, G, bid);
      pg8::EpiStoreSS<0> E{(bf16_t*)(ws + OFF_P), NP, ss, ss + M};
      pg8::gemm_phase<pg8::EpiStoreSS<0>, pg8::StaticOrder>(lds, g, S, E, nullptr, wid_s); }
    grid.sync();
    { pg8::Gemm g{(const bf16_t*)(ws + OFF_P), (const bf16_t*)(ws + OFF_WUQ), M, 768, 256, NP, 256}; pg8::StaticOrder S; S.init(M, 768, G, bid);
      pg8::EpiQ E{(bf16_t*)(ws + OFF_Q), ss, cosT, sinT};
      pg8::gemm_phase<pg8::EpiQ, pg8::StaticOrder>(lds, g, S, E, nullptr, wid_s); }
    { pg8::Gemm g{(const bf16_t*)(ws + OFF_P) + C_CKV, (const bf16_t*)(ws + OFF_WKN), M, 512, 128, NP, 256}; pg8::StaticOrder S; S.init(M, 512, G, bid);
      pg8::EpiKN E{(bf16_t*)(ws + OFF_K), ss + M};
      pg8::gemm_phase<pg8::EpiKN, pg8::StaticOrder>(lds, g, S, E, nullptr, wid_s); }
    { pg8::Gemm g{(const bf16_t*)(ws + OFF_WV), (const bf16_t*)(ws + OFF_P) + C_CKV, 512, M, 128, 256, NP}; pg8::StaticOrder S; S.init(512, M, G, bid);
      pg8::EpiVT E{(bf16_t*)(ws + OFF_VT), ss + M};
      pg8::gemm_phase<pg8::EpiVT, pg8::StaticOrder>(lds, g, S, E, nullptr, wid_s); }
    phase_krope(p, wid_s);
    grid.sync();
    for (int u = bid; u < 256; u += G) scan_unit(lds, p, u, wid_s);
    __syncthreads();
    for (int pr = bid; pr < 512; pr += G) { const int bh = pr >> 2, j = pr & 3;
        attn_item(lds, p, bh, 7 - j, wid_s);
        attn_item(lds, p, bh, j, wid_s); }
    grid.sync();
    if (G == M / 256) {
        { pg8::Gemm g{(const bf16_t*)(ws + OFF_U), (const bf16_t*)(ws + OFF_WOUT), M, 1024, 1024, 1024, 1024}; pg8::PanelOrder S{bid, 4};
          pg8::EpiStoreSS<1> E{(bf16_t*)(ws + OFF_OUT), 1024, ss + 2 * M, nullptr};
          pg8::gemm_phase<pg8::EpiStoreSS<1>, pg8::PanelOrder>(lds, g, S, E, nullptr, wid_s); }
        __threadfence(); __syncthreads();
        phase_final(p, wid_s, bid * 256, 256, 8, wid_s);
    } else {
        { pg8::Gemm g{(const bf16_t*)(ws + OFF_U), (const bf16_t*)(ws + OFF_WOUT), M, 1024, 1024, 1024, 1024}; pg8::StaticOrder S; S.init(M, 1024, G, bid);
          pg8::EpiStoreSS<1> E{(bf16_t*)(ws + OFF_OUT), 1024, ss + 2 * M, nullptr};
          pg8::gemm_phase<pg8::EpiStoreSS<1>, pg8::StaticOrder>(lds, g, S, E, nullptr, wid_s); }
        grid.sync();
        phase_final(p, wid_s, 0, M, G * 8, bid * 8 + wid_s);
    }
}

extern "C" void kernel_launch(void* const* d_in, const int* in_sizes, int n_in, void* d_out, int out_size, void* d_ws, size_t ws_size, hipStream_t stream) {
    static int grid = 0;
    if (grid == 0) {
        if (n_in != 20 || out_size != M * D || ws_size < WS_END) { fprintf(stderr, "kernel_launch: unexpected shapes (n_in %d, out %d, ws %zu < %zu)\n", n_in, out_size, ws_size, (size_t)WS_END); grid = -1; return; }
        int dev = 0, cus = 0, per_cu = 0;
        hipGetDevice(&dev); hipDeviceGetAttribute(&cus, hipDeviceAttributeMultiprocessorCount, dev);
        if (hipFuncSetAttribute((const void*)hymba_fwd, hipFuncAttributeMaxDynamicSharedMemorySize, LDS_BYTES) != hipSuccess) { fprintf(stderr, "kernel_launch: hipFuncSetAttribute failed\n"); grid = -1; return; }
        if (hipOccupancyMaxActiveBlocksPerMultiprocessor(&per_cu, (const void*)hymba_fwd, 512, LDS_BYTES) != hipSuccess || per_cu < 1) { fprintf(stderr, "kernel_launch: occupancy query gave %d\n", per_cu); per_cu = 1; (void)hipGetLastError(); }
        grid = cus;
    }
    if (grid < 0) return;
    Params p{};
    p.x = (const float*)d_in[0]; p.pos = (const int*)d_in[1]; p.g_pre = (const float*)d_in[2]; p.w_in = (const float*)d_in[3]; p.g_q = (const float*)d_in[4]; p.w_uq = (const float*)d_in[5];
    p.g_kv = (const float*)d_in[6]; p.w_ukv = (const float*)d_in[7]; p.mu = (const float*)d_in[8]; p.w0 = (const float*)d_in[9]; p.w2 = (const float*)d_in[10]; p.a0 = (const float*)d_in[11];
    p.a2 = (const float*)d_in[12]; p.k_k = (const float*)d_in[13]; p.k_a = (const float*)d_in[14]; p.r_k = (const float*)d_in[15]; p.ln_g = (const float*)d_in[16]; p.ln_b = (const float*)d_in[17];
    p.w_out = (const float*)d_in[18]; p.g_post = (const float*)d_in[19]; p.out = (float*)d_out; p.ws = (unsigned char*)d_ws;
    void* args[] = {&p};
    hipError_t e = hipLaunchCooperativeKernel((const void*)hymba_fwd, dim3(grid), dim3(512), args, LDS_BYTES, stream);
    if (e != hipSuccess) fprintf(stderr, "kernel_launch: cooperative launch failed: %s (grid %d)\n", hipGetErrorString(e), grid);
}
```
